# Optimizing an MI355X kernel written in HIP

```python
import jax, jax.numpy as jnp
from jax import lax
import numpy as np

D_MODEL = 1024
BATCH = 8
SEQ = 4096
DEPTH = 4

N_MIXERS = 2
EXPAND = 2
D_BRANCH = EXPAND * D_MODEL
CHUNK = 128
GMLP_GROUPS = 8
GMLP_GROUP_W = D_BRANCH // GMLP_GROUPS
LRU_HEADS = 8
LRU_HEAD_W = D_BRANCH // LRU_HEADS
CONV_WIDTH = 4
LRU_C = 8.0
N_A = (DEPTH + 1) // 2
N_B = DEPTH // 2
EPS = 1e-6

kernel_name = "hybrid_gmlp_rglru_sandwich_adaln"


def rms_norm(x, g):
    xf = x.astype(jnp.float32)
    y = xf * lax.rsqrt(jnp.mean(xf * xf, axis=-1, keepdims=True) + EPS)
    return (y * g.astype(jnp.float32)).astype(x.dtype)


def layer_norm(x, g):
    xf = x.astype(jnp.float32)
    xc = xf - jnp.mean(xf, axis=-1, keepdims=True)
    y = xc * lax.rsqrt(jnp.mean(xc * xc, axis=-1, keepdims=True) + EPS)
    return (y * g.astype(jnp.float32)).astype(x.dtype)


def gmlp_mixer(h, w_in, v_norm, w_s, b_s, w_out):
    b, s, _ = h.shape
    z = h @ w_in
    u, v, g = jnp.split(z, 3, axis=-1)
    u = jax.nn.gelu(u)
    v = layer_norm(jax.nn.gelu(v), v_norm)
    n_chunks = s // CHUNK
    v = v.reshape(b, n_chunks, CHUNK, GMLP_GROUPS, GMLP_GROUP_W)
    causal = jnp.tril(jnp.ones((CHUNK, CHUNK), dtype=bool))
    w = jnp.where(causal[None], w_s, jnp.zeros_like(w_s))
    mixed = jnp.einsum('gts,bnsgc->bntgc', w, v) + jnp.transpose(b_s)[None, None, :, :, None]
    y = u * mixed.reshape(b, s, D_BRANCH) * jax.nn.silu(g)
    return y @ w_out


def _lru_combine(left, right):
    a1, b1 = left
    a2, b2 = right
    return a1 * a2, a2 * b1 + b2


def rglru_mixer(h, w_in, conv_w, conv_b, ga_w, ga_b, gx_w, gx_b, lam, w_out):
    b, s, _ = h.shape
    z = h @ w_in
    xb, g = jnp.split(z, 2, axis=-1)
    xp = jnp.pad(xb, ((0, 0), (CONV_WIDTH - 1, 0), (0, 0)))
    xc = conv_b + xp[:, 0:s] * conv_w[0]
    for k in range(1, CONV_WIDTH):
        xc = xc + xp[:, k:k + s] * conv_w[k]
    xh = xc.reshape(b, s, LRU_HEADS, LRU_HEAD_W)
    r = jax.nn.sigmoid(jnp.einsum('bshi,hij->bshj', xh, ga_w).reshape(b, s, D_BRANCH) + ga_b)
    i = jax.nn.sigmoid(jnp.einsum('bshi,hij->bshj', xh, gx_w).reshape(b, s, D_BRANCH) + gx_b)
    log_a = -LRU_C * r.astype(jnp.float32) * jax.nn.softplus(-lam.astype(jnp.float32))
    a = jnp.exp(log_a)
    mult = jnp.sqrt(-jnp.expm1(2.0 * log_a))
    bterm = mult * (i * xc).astype(jnp.float32)
    _, hs = lax.associative_scan(_lru_combine, (a, bterm), axis=1)
    y = hs.astype(h.dtype) * jax.nn.silu(g)
    return y @ w_out


def setup_inputs(seed: int = 0) -> dict:
    key = jax.random.key(seed)
    ks = jax.random.split(key, 24)
    f32 = jnp.float32
    nrm = lambda k, shape, scale: jax.random.normal(k, shape, f32) * scale
    u_lam = jax.random.uniform(ks[23], (N_B, D_BRANCH), f32, minval=0.9, maxval=0.999)
    a_base = u_lam ** (1.0 / LRU_C)
    lam = jnp.log(a_base) - jnp.log1p(-a_base)
    return {
        "x": nrm(ks[0], (BATCH, SEQ, D_MODEL), 1.0),
        "c": nrm(ks[1], (BATCH, D_MODEL), 1.0),
        "mod_w": nrm(ks[2], (DEPTH, D_MODEL, 3 * D_MODEL), D_MODEL ** -0.5),
        "mod_b": nrm(ks[3], (DEPTH, 3 * D_MODEL), 0.02),
        "pre_norm": 1.0 + nrm(ks[4], (DEPTH, D_MODEL), 0.1),
        "post_norm": 1.0 + nrm(ks[5], (DEPTH, D_MODEL), 0.1),
        "a_w_in": nrm(ks[6], (N_A, D_MODEL, 3 * D_BRANCH), D_MODEL ** -0.5),
        "a_v_norm": 1.0 + nrm(ks[7], (N_A, D_BRANCH), 0.1),
        "a_w_s": nrm(ks[8], (N_A, GMLP_GROUPS, CHUNK, CHUNK), CHUNK ** -0.5),
        "a_b_s": 1.0 + nrm(ks[9], (N_A, GMLP_GROUPS, CHUNK), 0.1),
        "a_w_out": nrm(ks[10], (N_A, D_BRANCH, D_MODEL), D_BRANCH ** -0.5),
        "b_w_in": nrm(ks[11], (N_B, D_MODEL, 2 * D_BRANCH), D_MODEL ** -0.5),
        "b_conv_w": nrm(ks[12], (N_B, CONV_WIDTH, D_BRANCH), CONV_WIDTH ** -0.5),
        "b_conv_b": nrm(ks[13], (N_B, D_BRANCH), 0.01),
        "b_ga_w": nrm(ks[14], (N_B, LRU_HEADS, LRU_HEAD_W, LRU_HEAD_W), LRU_HEAD_W ** -0.5),
        "b_ga_b": nrm(ks[15], (N_B, D_BRANCH), 0.01),
        "b_gx_w": nrm(ks[16], (N_B, LRU_HEADS, LRU_HEAD_W, LRU_HEAD_W), LRU_HEAD_W ** -0.5),
        "b_gx_b": nrm(ks[17], (N_B, D_BRANCH), 0.01),
        "b_lambda": lam,
        "b_w_out": nrm(ks[18], (N_B, D_BRANCH, D_MODEL), D_BRANCH ** -0.5),
    }


def reference(x, c, mod_w, mod_b, pre_norm, post_norm,
              a_w_in, a_v_norm, a_w_s, a_b_s, a_w_out,
              b_w_in, b_conv_w, b_conv_b, b_ga_w, b_ga_b, b_gx_w, b_gx_b, b_lambda, b_w_out):
    cond = jax.nn.silu(c)
    for layer in range(DEPTH):
        mod = cond @ mod_w[layer] + mod_b[layer]
        shift, scale, gate = jnp.split(mod[:, None, :], 3, axis=-1)
        h = rms_norm(x, pre_norm[layer]) * (1.0 + scale) + shift
        j = layer // N_MIXERS
        if layer % N_MIXERS == 0:
            y = gmlp_mixer(h, a_w_in[j], a_v_norm[j], a_w_s[j], a_b_s[j], a_w_out[j])
        else:
            y = rglru_mixer(h, b_w_in[j], b_conv_w[j], b_conv_b[j], b_ga_w[j], b_ga_b[j],
                            b_gx_w[j], b_gx_b[j], b_lambda[j], b_w_out[j])
        x = x + gate * rms_norm(y, post_norm[layer])
    return x
```

```cpp
#include <hip/hip_runtime.h>
#include <hip/hip_cooperative_groups.h>
#include <cstdio>
namespace cg = cooperative_groups;

#define LAS __attribute__((address_space(3)))
typedef unsigned short bf16_t;
typedef short bf16x8 __attribute__((ext_vector_type(8)));
typedef float f32x4 __attribute__((ext_vector_type(4)));
typedef float f32x2 __attribute__((ext_vector_type(2)));
typedef unsigned u32x4 __attribute__((ext_vector_type(4)));
typedef unsigned u32x2 __attribute__((ext_vector_type(2)));

constexpr int D = 1024, NB = 8, SEQ = 4096, M = NB * SEQ, E = 2048, DEPTH = 4;
constexpr float EPS = 1e-6f;
constexpr size_t MiB = 1u << 20;
constexpr size_t WS_CTL = 0, CTL_ZERO_BYTES = 65536;
constexpr size_t WS_MOD = 1 * MiB;
constexpr size_t WS_NSP = 1 * MiB + 512 * 1024;
constexpr size_t WS_VSTAT = 2 * MiB;
constexpr size_t WS_SSQ = 6 * MiB;
constexpr size_t WS_CP = 8 * MiB, WS_CH = 12 * MiB;
constexpr size_t WS_W = 16 * MiB;
constexpr size_t WS_H = 32 * MiB;
constexpr size_t WS_R1 = 96 * MiB, WS_R3 = 224 * MiB, WS_R4 = 352 * MiB, WS_W2 = 480 * MiB, WS_END = 496 * MiB;
constexpr int LDS_BYTES = 156672, LDS_CTL_OFF = 131072, LDS_GB_OFF = LDS_CTL_OFF + 1024;

__device__ __forceinline__ unsigned cvt_pk_bf16(float lo, float hi) { unsigned r; asm volatile("v_cvt_pk_bf16_f32 %0, %1, %2" : "=v"(r) : "v"(lo), "v"(hi)); return r; }
__device__ __forceinline__ float bf_lo(unsigned w) { return __uint_as_float(w << 16); }
__device__ __forceinline__ float bf_hi(unsigned w) { return __uint_as_float(w & 0xffff0000u); }
__device__ __forceinline__ float fsigmoid(float x) { return __builtin_amdgcn_rcpf(1.0f + __builtin_amdgcn_exp2f(-1.44269504f * x)); }
__device__ __forceinline__ float fsilu(float x) { return x * fsigmoid(x); }
__device__ __forceinline__ float fgelu(float x) { const float u = x * (1.0f + 0.044715f * x * x); return x * fsigmoid(1.59576912f * u); }
__device__ __forceinline__ float fexp(float x) { return __builtin_amdgcn_exp2f(1.44269504f * x); }
__device__ __forceinline__ float wave_sum(float v) {
#pragma unroll
    for (int o = 1; o < 64; o <<= 1) v += __shfl_xor(v, o);
    return v;
}
#define LDS_WAIT() asm volatile("s_waitcnt lgkmcnt(0)" ::: "memory")
template <class T> __device__ __forceinline__ T ntload(const T* p) { return __builtin_nontemporal_load(p); }
__device__ __forceinline__ int ltid(int sw) { unsigned z = 0u; asm volatile("" : "+s"(sw), "+s"(z)); int t = sw * 64 + (int)__builtin_amdgcn_mbcnt_hi(~0u, __builtin_amdgcn_mbcnt_lo(~0u, z)); asm volatile("" : "+v"(t)); return t; }
__device__ __forceinline__ int lbid() { int t = blockIdx.x; asm volatile("" : "+s"(t)); return t; }
__device__ __forceinline__ int lgrid() { int t = gridDim.x; asm volatile("" : "+s"(t)); return t; }
struct View { int vb, vG, row0, MR; };
__device__ __forceinline__ View lview(View v) { asm volatile("" : "+s"(v.vb), "+s"(v.vG), "+s"(v.row0), "+s"(v.MR)); return v; }

#define XB_TMO      128
#define XB_XCNT(j)  (256  + 64 * (j))
#define XB_XSUB(j)  (1280 + 64 * (j))
#define XB_XGEN(j)  (2304 + 64 * (j))
#define XB_TOP      3328
#define XB_TOPGEN   3392
#define XCD_BAR_WORDS 3456
#define XB_SPIN_CAP (1u << 20)
__device__ __forceinline__ unsigned xb_ld(unsigned* p)              { return __hip_atomic_load(p, __ATOMIC_RELAXED, __HIP_MEMORY_SCOPE_AGENT); }
__device__ __forceinline__ unsigned xb_add(unsigned* p, unsigned v) { return __hip_atomic_fetch_add(p, v, __ATOMIC_RELAXED, __HIP_MEMORY_SCOPE_AGENT); }
__device__ __forceinline__ unsigned xb_xcc_id() { return (unsigned)__builtin_amdgcn_s_getreg((3 << 11) | 20) & 0xFu; }
#define XB_SPIN(cond, bar) do { unsigned _sp = 0; while (cond) { __builtin_amdgcn_s_sleep(1); \
    if ((++_sp & 255u) == 0u) { if (xb_ld(&(bar)[XB_TMO])) break; if (_sp > XB_SPIN_CAP) { atomicAdd(&(bar)[XB_TMO], 1u); break; } } } } while (0)
struct XcdBarrier { unsigned* bar; unsigned x; volatile LAS unsigned* st; };
__device__ __forceinline__ XcdBarrier xcd_barrier_post(unsigned* bar, volatile LAS unsigned* st) {
    XcdBarrier b; b.bar = bar; b.x = xb_xcc_id(); b.st = st;
    if (threadIdx.x == 0) st[3] = xb_add(&bar[XB_XCNT(b.x)], 1u);
    return b;
}
__device__ __forceinline__ void xcd_barrier_complete(unsigned* bar, unsigned x, unsigned& nloc, unsigned& nx) {
    const unsigned G = gridDim.x * gridDim.y * gridDim.z;
    unsigned sum, cnt, mine, sp = 0u;
    for (;;) {
        sum = 0u; cnt = 0u; mine = 0u;
#pragma unroll
        for (unsigned j = 0; j < 16; ++j) { const unsigned c = xb_ld(&bar[XB_XCNT(j)]); sum += c; cnt += (c > 0u) ? 1u : 0u; mine = (j == x) ? c : mine; }
        if (sum == G) break;
        __builtin_amdgcn_s_sleep(1);
        if ((++sp & 255u) == 0u) { if (xb_ld(&bar[XB_TMO])) break; if (sp > XB_SPIN_CAP) { atomicAdd(&bar[XB_TMO], 1u); break; } }
    }
    nloc = mine > 0u ? mine : 1u; nx = cnt > 0u ? cnt : 1u;
}
__device__ __forceinline__ void xcd_barrier(const XcdBarrier& b, int local) {
    asm volatile("s_waitcnt vmcnt(0)" ::: "memory");
    __syncthreads();
    if (threadIdx.x == 0) {
        unsigned* bar = b.bar;
        __builtin_amdgcn_s_waitcnt(0);
        unsigned nloc = b.st[0], nx = b.st[1];
        if (nloc == 0u) { xcd_barrier_complete(bar, b.x, nloc, nx); b.st[0] = nloc; b.st[1] = nx; }
        const unsigned old = xb_add(&bar[XB_XSUB(b.x)], 1u);
        const unsigned gen = old / nloc;
        if (old + 1u == (gen + 1u) * nloc) {
            if (!local) {
            __builtin_amdgcn_fence(__ATOMIC_RELEASE, "agent");
            asm volatile("s_waitcnt vmcnt(0)" ::: "memory");
            const unsigned og = xb_add(&bar[XB_TOP], 1u);
            const unsigned tg = og / nx;
            if (og + 1u == (tg + 1u) * nx) xb_add(&bar[XB_TOPGEN], 1u);
            else XB_SPIN(xb_ld(&bar[XB_TOPGEN]) == tg, bar);
            }
            __builtin_amdgcn_fence(__ATOMIC_ACQUIRE, "agent");
            xb_add(&bar[XB_XGEN(b.x)], 1u);
            asm volatile("s_waitcnt vmcnt(0)" ::: "memory");
        } else {
            XB_SPIN(xb_ld(&bar[XB_XGEN(b.x)]) == gen, bar);
            __builtin_amdgcn_fence(__ATOMIC_ACQUIRE, "agent");
            asm volatile("s_waitcnt vmcnt(0)" ::: "memory");
        }
    }
    __syncthreads();
}

namespace pg8 {
constexpr int BM = 256, BK = 64, HALF = 128, HTB = HALF * BK * 2, STAGE_BYTES = 8 * HTB, NXCD = 8, WGM = 8;
__device__ __forceinline__ int lds_byte(int r, int c) { const int st = (r >> 4) * 2 + (c >> 5), rr = r & 15, cc = c & 31, ob = rr * 64 + cc * 2; return st * 1024 + (ob ^ (((ob >> 9) & 1) << 5)); }
__device__ __forceinline__ void stage_rc(int b, int& R, int& C) { const int st = b / 1024, sb = b % 1024, swz = sb ^ (((sb >> 9) & 1) << 5); R = (st >> 1) * 16 + swz / 64; C = (st & 1) * 32 + (swz % 64) / 2; }
__device__ __forceinline__ int perm32(int rho) { const int n = rho >> 4, i = rho & 15; return 8 * (i >> 2) + 4 * n + (i & 3); }

struct Unit { int pm, pn; };
struct Gemm { const bf16_t* A; const bf16_t* Bt; int lda, ldb, K, acol; };
struct StaticOrder {
    int nM, nN, nwg, G, c, sticky;
    __device__ void init(int nM_, int nN_, int G_, int c_) { nM = nM_; nN = nN_; nwg = nM * nN; G = G_; c = c_; sticky = 0; }
    __device__ bool next(int i, Unit& u) const {
        if (sticky) { u.pn = c % nN; u.pm = c / nN + i * (G / nN); return u.pm < nM; }
        const long L = (long)i * G + c; if (L >= nwg) return false;
        int wgid = (int)L; { const int q = nwg / NXCD, r = nwg % NXCD, xcd = wgid % NXCD, off = wgid / NXCD; wgid = (xcd < r ? xcd * (q + 1) : r * (q + 1) + (xcd - r) * q) + off; }
        const int nig = WGM * nN, gid = wgid / nig, fm = gid * WGM, gsz = (nM - fm) < WGM ? (nM - fm) : WGM;
        u.pm = fm + ((wgid % nig) % gsz); u.pn = (wgid % nig) / gsz; return true;
    }
};

template <class Epi>
__device__ __forceinline__ void gemm_phase(LAS unsigned char* lds, const Gemm g, const StaticOrder& S_in, const Epi& E, int sw) {
    StaticOrder S = S_in; asm volatile("" : "+s"(S.c), "+s"(S.G));
    const int tid = ltid(sw);
    const int wid = __builtin_amdgcn_readfirstlane(tid >> 6), lane = tid & 63, wr = wid >> 2, wc = wid & 3, fr = lane & 15, fq = lane >> 4;
    const int K = g.K, nt = K / BK;
    unsigned voffA[2], voffB[2];
#pragma unroll
    for (int i = 0; i < 2; ++i) { int R, C; stage_rc(tid * 16 + i * 8192, R, C); const int Rb = (R & ~31) + perm32(R & 31);
        voffA[i] = (unsigned)(R * g.lda + C) * 2u; voffB[i] = (unsigned)(Rb * g.ldb + C) * 2u; }
    const size_t kstep = (size_t)(BK * 2);
    const size_t hstepA = (size_t)HALF * g.lda * 2, hstepB = (size_t)HALF * g.ldb * 2;
    const unsigned ldsw = (unsigned)wid * 1024u;
    const int aoff = lds_byte(wr * 64 + fr, fq * 8), boff = lds_byte(wc * 32 + fr, fq * 8);
#define PG8_SA(b, h) (((b) * 2 + (h)) * HTB)
#define PG8_SB(b, h) ((4 + (b) * 2 + (h)) * HTB)
#define PG8_STAGE(bufoff, gbase, voff) do { _Pragma("unroll") for (int _i = 0; _i < 2; ++_i) \
        __builtin_amdgcn_global_load_lds((const __attribute__((address_space(1))) unsigned*)((const char*)(gbase) + (voff)[_i]), (LAS unsigned*)(lds + (bufoff) + ldsw + _i * 8192), 16, 0, 0); } while (0)
#define PG8_LDA(dst, b, h) do { _Pragma("unroll") for (int m = 0; m < 4; ++m) _Pragma("unroll") for (int k = 0; k < 2; ++k) dst[m][k] = *(const LAS bf16x8*)(lds + PG8_SA(b, h) + aoff + m * 2048 + k * 1024); } while (0)
#define PG8_LDB(dst, b, h) do { _Pragma("unroll") for (int n = 0; n < 2; ++n) _Pragma("unroll") for (int k = 0; k < 2; ++k) dst[n][k] = *(const LAS bf16x8*)(lds + PG8_SB(b, h) + boff + n * 2048 + k * 1024); } while (0)
#define PG8_MMA(ai, bj, At, Bt) do { __builtin_amdgcn_s_setprio(1); _Pragma("unroll") for (int m = 0; m < 4; ++m) _Pragma("unroll") for (int n = 0; n < 2; ++n) _Pragma("unroll") for (int k = 0; k < 2; ++k) \
        acc[ai][bj][m][n] = __builtin_amdgcn_mfma_f32_16x16x32_bf16(Bt[n][k], At[m][k], acc[ai][bj][m][n], 0, 0, 0); __builtin_amdgcn_s_setprio(0); } while (0)
#define PG8_WAIT_V(n) asm volatile("s_waitcnt vmcnt(" #n ")" ::: "memory")
#define PG8_WAIT_L(n) asm volatile("s_waitcnt lgkmcnt(" #n ")" ::: "memory")
#define PG8_BAR __builtin_amdgcn_s_barrier()
#define PG8_SCHED __builtin_amdgcn_sched_barrier(0)
#define PG8_ABASE(u) ((const char*)g.A + ((size_t)(u).pm * BM * g.lda + (size_t)((u).pn >> 1) * g.acol) * 2)
#define PG8_BBASE(u) ((const char*)g.Bt + (size_t)(u).pn * BM * g.ldb * 2)
    Unit cur, nxt; int ui = 0;
    if (!S.next(0, cur)) return;
    f32x4 acc[2][2][4][2];
    E.init(acc, cur, sw);
    bf16x8 At[4][2], B0[2][2], B1[2][2];
    const char* cA = PG8_ABASE(cur); const char* cB = PG8_BBASE(cur);
    PG8_STAGE(PG8_SB(0, 0), cB, voffB); PG8_STAGE(PG8_SA(0, 0), cA, voffA); PG8_STAGE(PG8_SB(0, 1), cB + hstepB, voffB); PG8_STAGE(PG8_SA(0, 1), cA + hstepA, voffA);
    if (wr == 1) PG8_BAR;
    PG8_WAIT_V(4); PG8_BAR;
    PG8_STAGE(PG8_SB(1, 0), cB + kstep, voffB); PG8_STAGE(PG8_SA(1, 0), cA + kstep, voffA); PG8_STAGE(PG8_SB(1, 1), cB + hstepB + kstep, voffB);
    PG8_WAIT_V(6); PG8_BAR;
    for (;;) {
        const bool has_next = S.next(ui + 1, nxt);
        const char* nA = has_next ? PG8_ABASE(nxt) : cA; const char* nB = has_next ? PG8_BBASE(nxt) : cB;
        for (int t = 0; t < nt; t += 2) {
            const bool last = (t == nt - 2);
            const char* a1 = cA + (size_t)(t + 1) * kstep;
            const char* a2 = last ? nA : cA + (size_t)(t + 2) * kstep; const char* b2 = last ? nB : cB + (size_t)(t + 2) * kstep;
            const char* a3 = a2 + kstep; const char* b3 = b2 + kstep;
            PG8_LDB(B0, 0, 0); PG8_SCHED; PG8_LDA(At, 0, 0); PG8_STAGE(PG8_SA(1, 1), a1 + hstepA, voffA);
            PG8_WAIT_L(8); PG8_BAR; PG8_WAIT_L(0); PG8_MMA(0, 0, At, B0); PG8_BAR; PG8_SCHED;
            PG8_LDB(B1, 0, 1); PG8_STAGE(PG8_SB(0, 0), b2, voffB);
            PG8_BAR; PG8_WAIT_L(0); PG8_MMA(0, 1, At, B1); PG8_BAR;
            PG8_LDA(At, 0, 1); PG8_STAGE(PG8_SA(0, 0), a2, voffA);
            PG8_BAR; PG8_WAIT_L(0); PG8_MMA(1, 0, At, B0); PG8_BAR; PG8_SCHED;
            PG8_STAGE(PG8_SB(0, 1), b2 + hstepB, voffB);
            PG8_WAIT_V(6); PG8_BAR; PG8_MMA(1, 1, At, B1); PG8_BAR;
            PG8_LDB(B0, 1, 0); PG8_SCHED; PG8_LDA(At, 1, 0); PG8_STAGE(PG8_SA(0, 1), a2 + hstepA, voffA);
            PG8_WAIT_L(8); PG8_BAR; PG8_WAIT_L(0); PG8_MMA(0, 0, At, B0); PG8_BAR; PG8_SCHED;
            PG8_LDB(B1, 1, 1); PG8_STAGE(PG8_SB(1, 0), b3, voffB);
            PG8_BAR; PG8_WAIT_L(0); PG8_MMA(0, 1, At, B1); PG8_BAR;
            PG8_LDA(At, 1, 1); PG8_STAGE(PG8_SA(1, 0), a3, voffA);
            PG8_BAR; PG8_WAIT_L(0); PG8_MMA(1, 0, At, B0); PG8_BAR; PG8_SCHED;
            PG8_STAGE(PG8_SB(1, 1), b3 + hstepB, voffB);
            PG8_WAIT_V(6); PG8_BAR; PG8_MMA(1, 1, At, B1); PG8_BAR;
        }
        __builtin_amdgcn_sched_barrier(0);
        E(acc, cur, sw);
        __builtin_amdgcn_sched_barrier(0);
        if (!has_next) break;
        E.init(acc, nxt, sw);
        cur = nxt; cA = nA; cB = nB; ++ui;
    }
    PG8_WAIT_V(0);
    if (wr == 0) PG8_BAR;
    PG8_BAR;
#undef PG8_SA
#undef PG8_SB
#undef PG8_STAGE
#undef PG8_LDA
#undef PG8_LDB
#undef PG8_MMA
#undef PG8_WAIT_V
#undef PG8_WAIT_L
#undef PG8_BAR
#undef PG8_SCHED
#undef PG8_ABASE
#undef PG8_BBASE
}

template <int K> __device__ __forceinline__ float row_ror(float v) { return __int_as_float(__builtin_amdgcn_update_dpp(0, __float_as_int(v), 0x120 + K, 0xF, 0xF, false)); }
typedef const f32x4 (&AccRef)[2][2][4][2];
typedef f32x4 (&AccMut)[2][2][4][2];
__device__ __forceinline__ void acc_zero(AccMut acc) {
#pragma unroll
    for (int a = 0; a < 2; ++a)
#pragma unroll
        for (int b = 0; b < 2; ++b)
#pragma unroll
            for (int m = 0; m < 4; ++m)
#pragma unroll
                for (int n = 0; n < 2; ++n) acc[a][b][m][n] = (f32x4){0.f, 0.f, 0.f, 0.f};
}
#define EPI_ZERO_INIT __device__ __forceinline__ void init(AccMut acc, const Unit&, int) const { acc_zero(acc); }
template <int ACT> struct EpiPlain {
    bf16_t* O; int ldc;
    EPI_ZERO_INIT
    __device__ __forceinline__ void operator()(AccRef acc, const Unit& u, int sw) const {
        const int tid_ = ltid(sw), lane_ = tid_ & 63, wr = sw >> 2, wc = sw & 3, fr = lane_ & 15, fq = lane_ >> 4;
        const int row0 = u.pm * BM + wr * 64 + fr, col0 = u.pn * BM + wc * 32 + 8 * fq;
#pragma unroll
        for (int ai = 0; ai < 2; ++ai)
#pragma unroll
            for (int m = 0; m < 4; ++m) { bf16_t* rowp = O + (size_t)(row0 + ai * HALF + m * 16) * ldc + col0;
#pragma unroll
                for (int bj = 0; bj < 2; ++bj) { f32x4 v0 = acc[ai][bj][m][0], v1 = acc[ai][bj][m][1];
                    if (ACT == 1) {
#pragma unroll
                        for (int j = 0; j < 4; ++j) { v0[j] = fsilu(v0[j]); v1[j] = fsilu(v1[j]); } }
                    u32x4 w; w.x = cvt_pk_bf16(v0[0], v0[1]); w.y = cvt_pk_bf16(v0[2], v0[3]); w.z = cvt_pk_bf16(v1[0], v1[1]); w.w = cvt_pk_bf16(v1[2], v1[3]);
                    *(u32x4*)(rowp + bj * HALF) = w; } }
    }
};
struct EpiUG {
    bf16_t* UG;
    EPI_ZERO_INIT
    __device__ __forceinline__ void operator()(AccRef acc, const Unit& u, int sw) const {
        const int tid_ = ltid(sw), lane_ = tid_ & 63, wr = sw >> 2, wc = sw & 3, fr = lane_ & 15, fq = lane_ >> 4;
        const int row0 = u.pm * BM + wr * 64 + fr, c0 = u.pn * 128 + wc * 32 + 8 * fq;
#pragma unroll
        for (int ai = 0; ai < 2; ++ai)
#pragma unroll
            for (int m = 0; m < 4; ++m) { bf16_t* rowp = UG + (size_t)(row0 + ai * HALF + m * 16) * E + c0;
                float y[8];
#pragma unroll
                for (int n = 0; n < 2; ++n)
#pragma unroll
                    for (int jp = 0; jp < 2; ++jp) {
                        const f32x2 uu = (f32x2){acc[ai][0][m][n][2 * jp], acc[ai][0][m][n][2 * jp + 1]}, gg = (f32x2){acc[ai][1][m][n][2 * jp], acc[ai][1][m][n][2 * jp + 1]};
                        const f32x2 za = (uu * uu * 0.044715f + 1.0f) * uu * (-1.44269504f * 1.59576912f), zg = gg * (-1.44269504f);
                        f32x2 ea, eg; ea.x = __builtin_amdgcn_exp2f(za.x); ea.y = __builtin_amdgcn_exp2f(za.y); eg.x = __builtin_amdgcn_exp2f(zg.x); eg.y = __builtin_amdgcn_exp2f(zg.y);
                        const f32x2 den = (ea + 1.0f) * (eg + 1.0f);
                        f32x2 rc; rc.x = __builtin_amdgcn_rcpf(den.x); rc.y = __builtin_amdgcn_rcpf(den.y);
                        const f32x2 yy = uu * gg * rc;
                        y[4 * n + 2 * jp] = yy.x; y[4 * n + 2 * jp + 1] = yy.y; }
                u32x4 w; w.x = cvt_pk_bf16(y[0], y[1]); w.y = cvt_pk_bf16(y[2], y[3]); w.z = cvt_pk_bf16(y[4], y[5]); w.w = cvt_pk_bf16(y[6], y[7]);
                *(u32x4*)rowp = w; }
    }
};
struct EpiVt {
    bf16_t* Vt; f32x2* VSTAT;
    EPI_ZERO_INIT
    __device__ __forceinline__ void operator()(AccRef acc, const Unit& u, int sw) const {
        const int tid_ = ltid(sw), lane_ = tid_ & 63, wr = sw >> 2, wc = sw & 3, fr = lane_ & 15, fq = lane_ >> 4;
        const int row0 = u.pm * BM + wr * 64 + fr, col0 = u.pn * BM + wc * 32 + 8 * fq;
#pragma unroll
        for (int bj = 0; bj < 2; ++bj) {
            float cs[2][4], cq[2][4];
#pragma unroll
            for (int n = 0; n < 2; ++n)
#pragma unroll
                for (int j = 0; j < 4; ++j) { cs[n][j] = 0.f; cq[n][j] = 0.f; }
#pragma unroll
            for (int ai = 0; ai < 2; ++ai)
#pragma unroll
                for (int m = 0; m < 4; ++m) { bf16_t* rowp = Vt + ((size_t)(2 * u.pn + bj) * E + (row0 + ai * HALF + m * 16)) * 128 + wc * 32 + 8 * fq;
                    f32x4 v0 = acc[ai][bj][m][0], v1 = acc[ai][bj][m][1];
#pragma unroll
                    for (int j = 0; j < 4; ++j) { v0[j] = fgelu(v0[j]); v1[j] = fgelu(v1[j]);
                        cs[0][j] += v0[j]; cq[0][j] += v0[j] * v0[j]; cs[1][j] += v1[j]; cq[1][j] += v1[j] * v1[j]; }
                    u32x4 w; w.x = cvt_pk_bf16(v0[0], v0[1]); w.y = cvt_pk_bf16(v0[2], v0[3]); w.z = cvt_pk_bf16(v1[0], v1[1]); w.w = cvt_pk_bf16(v1[2], v1[3]);
                    *(u32x4*)rowp = w; }
            f32x2* sp = VSTAT + (size_t)(u.pm * 2 + wr) * M + col0 + bj * HALF;
#pragma unroll
            for (int n = 0; n < 2; ++n)
#pragma unroll
                for (int j = 0; j < 4; ++j) { float s = cs[n][j], q = cq[n][j];
                    s += row_ror<8>(s); q += row_ror<8>(q); s += row_ror<4>(s); q += row_ror<4>(q);
                    s += row_ror<2>(s); q += row_ror<2>(q); s += row_ror<1>(s); q += row_ror<1>(q);
                    if (fr == 0) sp[4 * n + j] = (f32x2){s, q}; }
        }
    }
};
struct EpiOut {
    bf16_t* O; float* SSQ;
    EPI_ZERO_INIT
    __device__ __forceinline__ void operator()(AccRef acc, const Unit& u, int sw) const {
        const int tid_ = ltid(sw), lane_ = tid_ & 63, wr = sw >> 2, wc = sw & 3, fr = lane_ & 15, fq = lane_ >> 4;
        const int row0 = u.pm * BM + wr * 64 + fr, col0 = u.pn * BM + wc * 32 + 8 * fq;
#pragma unroll
        for (int ai = 0; ai < 2; ++ai)
#pragma unroll
            for (int m = 0; m < 4; ++m) { const int row = row0 + ai * HALF + m * 16; bf16_t* rowp = O + (size_t)row * D + col0; float s = 0.f;
#pragma unroll
                for (int bj = 0; bj < 2; ++bj) { const f32x4 v0 = acc[ai][bj][m][0], v1 = acc[ai][bj][m][1];
                    s += (v0[0] * v0[0] + v0[1] * v0[1]) + (v0[2] * v0[2] + v0[3] * v0[3]) + (v1[0] * v1[0] + v1[1] * v1[1]) + (v1[2] * v1[2] + v1[3] * v1[3]);
                    u32x4 w; w.x = cvt_pk_bf16(v0[0], v0[1]); w.y = cvt_pk_bf16(v0[2], v0[3]); w.z = cvt_pk_bf16(v1[0], v1[1]); w.w = cvt_pk_bf16(v1[2], v1[3]);
                    *(u32x4*)(rowp + bj * HALF) = w; }
                s += __shfl_xor(s, 16); s += __shfl_xor(s, 32);
                if (fq == 0) SSQ[(size_t)row * 16 + u.pn * 4 + wc] = s; }
    }
};
struct EpiConv {
    bf16_t* XC; bf16_t* XBE; const LAS float* cl;
    EPI_ZERO_INIT
    __device__ __forceinline__ void operator()(AccRef acc, const Unit& u, int sw) const {
        const int tid_ = ltid(sw), lane_ = tid_ & 63, wr = sw >> 2, wc = sw & 3, fr = lane_ & 15, fq = lane_ >> 4;
        const int row0 = u.pm * BM + wr * 64 + fr, col0 = u.pn * BM + wc * 32 + 8 * fq;
        const bool s1 = fr >= 15, s2 = fr >= 14, s3 = fr >= 13;
#pragma unroll
        for (int bj = 0; bj < 2; ++bj) { const int c = col0 + bj * HALF;
            f32x4 w0[2], w1[2], w2[2], w3[2], bb[2];
#pragma unroll
            for (int n = 0; n < 2; ++n) { const int cc = bj * HALF + wc * 32 + 8 * fq + 4 * n;
                w0[n] = *(const LAS f32x4*)(cl + 0 * 256 + cc); w1[n] = *(const LAS f32x4*)(cl + 1 * 256 + cc); w2[n] = *(const LAS f32x4*)(cl + 2 * 256 + cc);
                w3[n] = *(const LAS f32x4*)(cl + 3 * 256 + cc); bb[n] = *(const LAS f32x4*)(cl + 4 * 256 + cc); }
#pragma unroll
            for (int ai = 0; ai < 2; ++ai)
#pragma unroll
                for (int m = 0; m < 4; ++m) { const size_t off = (size_t)(row0 + ai * HALF + m * 16) * E + c;
                    float y[8], x0[8];
#pragma unroll
                    for (int n = 0; n < 2; ++n)
#pragma unroll
                        for (int j = 0; j < 4; ++j) { const float cur = acc[ai][bj][m][n][j], prev = (m > 0) ? acc[ai][bj][m > 0 ? m - 1 : 0][n][j] : 0.f;
                            const float x1 = row_ror<1>(s1 ? prev : cur), x2 = row_ror<2>(s2 ? prev : cur), x3 = row_ror<3>(s3 ? prev : cur);
                            x0[4 * n + j] = cur;
                            y[4 * n + j] = bb[n][j] + w0[n][j] * x3 + w1[n][j] * x2 + w2[n][j] * x1 + w3[n][j] * cur; }
                    if (m > 0 || fr >= 3) { u32x4 w; w.x = cvt_pk_bf16(y[0], y[1]); w.y = cvt_pk_bf16(y[2], y[3]); w.z = cvt_pk_bf16(y[4], y[5]); w.w = cvt_pk_bf16(y[6], y[7]);
                        *(u32x4*)(XC + off) = w; }
                    if ((m == 0 && fr < 3) || (m == 3 && fr >= 13)) { u32x4 w; w.x = cvt_pk_bf16(x0[0], x0[1]); w.y = cvt_pk_bf16(x0[2], x0[3]); w.z = cvt_pk_bf16(x0[4], x0[5]); w.w = cvt_pk_bf16(x0[6], x0[7]);
                        *(u32x4*)(XBE + off) = w; } }
        }
    }
};
struct EpiGate {
    const bf16_t* XC; bf16_t* LA; bf16_t* BT; const LAS float* gab; const LAS float* gxb; const LAS float* nsp;
    __device__ __forceinline__ void init(AccMut acc, const Unit& u, int sw) const {
        const int tid_ = ltid(sw), lane_ = tid_ & 63, wc = sw & 3, fq = lane_ >> 4;
        const int c0 = u.pn * 128 + wc * 32 + 8 * fq;
#pragma unroll
        for (int n = 0; n < 2; ++n) { const f32x4 ga = *(const LAS f32x4*)(gab + c0 + 4 * n), gx = *(const LAS f32x4*)(gxb + c0 + 4 * n);
#pragma unroll
            for (int ai = 0; ai < 2; ++ai)
#pragma unroll
                for (int m = 0; m < 4; ++m) { acc[ai][0][m][n] = ga; acc[ai][1][m][n] = gx; } }
    }
    __device__ __forceinline__ void operator()(AccMut acc, const Unit& u, int sw) const {
        const int tid_ = ltid(sw), lane_ = tid_ & 63, wr = sw >> 2, wc = sw & 3, fr = lane_ & 15, fq = lane_ >> 4;
        const int row0 = u.pm * BM + wr * 64 + fr, c0 = u.pn * 128 + wc * 32 + 8 * fq;
        u32x4 xnext = *(const u32x4*)(XC + (size_t)row0 * E + c0);
        { f32x4 ns[2];
#pragma unroll
          for (int n = 0; n < 2; ++n) ns[n] = *(const LAS f32x4*)(nsp + c0 + 4 * n);
#pragma unroll
          for (int ai = 0; ai < 2; ++ai)
#pragma unroll
            for (int m = 0; m < 4; ++m) {
#pragma unroll
                for (int n = 0; n < 2; ++n)
#pragma unroll
                    for (int jp = 0; jp < 2; ++jp) {
                        const f32x2 z = (f32x2){acc[ai][0][m][n][2 * jp], acc[ai][0][m][n][2 * jp + 1]} * (-1.44269504f);
                        f32x2 e; e.x = __builtin_amdgcn_exp2f(z.x); e.y = __builtin_amdgcn_exp2f(z.y); e = e + 1.0f;
                        f32x2 r; r.x = __builtin_amdgcn_rcpf(e.x); r.y = __builtin_amdgcn_rcpf(e.y);
                        r = r * (f32x2){ns[n][2 * jp], ns[n][2 * jp + 1]};
                        acc[ai][0][m][n][2 * jp] = r.x; acc[ai][0][m][n][2 * jp + 1] = r.y; }
                const f32x4 l0 = acc[ai][0][m][0], l1 = acc[ai][0][m][1];
                u32x4 w; w.x = cvt_pk_bf16(l0[0], l0[1]); w.y = cvt_pk_bf16(l0[2], l0[3]); w.z = cvt_pk_bf16(l1[0], l1[1]); w.w = cvt_pk_bf16(l1[2], l1[3]);
                *(u32x4*)(LA + (size_t)(row0 + ai * HALF + m * 16) * E + c0) = w; } }
#pragma unroll
        for (int ai = 0; ai < 2; ++ai)
#pragma unroll
            for (int m = 0; m < 4; ++m) { const size_t off = (size_t)(row0 + ai * HALF + m * 16) * E + c0;
                const u32x4 xw = xnext;
                if (ai * 4 + m < 7) { const int ai2 = (ai * 4 + m + 1) >> 2, m2 = (ai * 4 + m + 1) & 3; xnext = *(const u32x4*)(XC + (size_t)(row0 + ai2 * HALF + m2 * 16) * E + c0); }
                float bt[8];
#pragma unroll
                for (int n = 0; n < 2; ++n)
#pragma unroll
                    for (int jp = 0; jp < 2; ++jp) {
                        const f32x2 z = (f32x2){acc[ai][1][m][n][2 * jp], acc[ai][1][m][n][2 * jp + 1]} * (-1.44269504f);
                        f32x2 e; e.x = __builtin_amdgcn_exp2f(z.x); e.y = __builtin_amdgcn_exp2f(z.y); e = e + 1.0f;
                        f32x2 ig; ig.x = __builtin_amdgcn_rcpf(e.x); ig.y = __builtin_amdgcn_rcpf(e.y);
                        const f32x2 x2 = (f32x2){acc[ai][0][m][n][2 * jp], acc[ai][0][m][n][2 * jp + 1]} * 2.0f;
                        f32x2 ser = x2 * (1.0f / 120.0f) + (1.0f / 24.0f); ser = ser * x2 + (1.0f / 6.0f); ser = ser * x2 + 0.5f; ser = ser * x2 + 1.0f; ser = ser * (-x2);
                        f32x2 em = ser;
                        if (__builtin_expect(__builtin_amdgcn_ballot_w64(x2.x <= -0.25f || x2.y <= -0.25f) != 0ull, 0)) {
                            em.x = (x2.x > -0.25f) ? ser.x : (1.0f - fexp(x2.x)); em.y = (x2.y > -0.25f) ? ser.y : (1.0f - fexp(x2.y)); }
                        const unsigned wv = xw[2 * n + jp];
                        f32x2 sq; sq.x = __builtin_amdgcn_sqrtf(em.x); sq.y = __builtin_amdgcn_sqrtf(em.y);
                        const f32x2 b2 = sq * ig * (f32x2){bf_lo(wv), bf_hi(wv)};
                        bt[4 * n + 2 * jp] = b2.x; bt[4 * n + 2 * jp + 1] = b2.y; }
                u32x4 w; w.x = cvt_pk_bf16(bt[0], bt[1]); w.y = cvt_pk_bf16(bt[2], bt[3]); w.z = cvt_pk_bf16(bt[4], bt[5]); w.w = cvt_pk_bf16(bt[6], bt[7]);
                *(u32x4*)(BT + off) = w; }
    }
};
}

struct Args { const float* in[20]; float* out; unsigned char* ws; };
extern __shared__ __attribute__((aligned(16))) unsigned char lds_raw[];
__device__ __forceinline__ const float* argp(int i) {
    const __attribute__((address_space(4))) unsigned long long* kp = (const __attribute__((address_space(4))) unsigned long long*)__builtin_amdgcn_kernarg_segment_ptr();
    asm volatile("" : "+s"(kp));
    return (const float*)(const __attribute__((address_space(1))) float*)kp[i];
}
#define ARG_OUT ((float*)argp(20))
#define ARG_WS ((unsigned char*)argp(21))
enum { I_X = 0, I_C, I_MODW, I_MODB, I_PRE, I_POST, I_AWIN, I_AVN, I_AWS, I_ABS, I_AWOUT, I_BWIN, I_BCW, I_BCB, I_BGAW, I_BGAB, I_BGXW, I_BGXB, I_BLAM, I_BWOUT };

__device__ __forceinline__ void tr_item(const float* W, int ldw, int k0, int n0, bf16_t* WT, int ldt, int drow0, LAS float* scr, int lane) {
#pragma unroll 8
    for (int i = 0; i < 32; ++i) { const int kk = 2 * i + (lane >> 5); scr[kk * 33 + (lane & 31)] = ntload(W + (size_t)(k0 + kk) * ldw + n0 + (lane & 31)); }
    LDS_WAIT();
    const int c = lane & 7;
#pragma unroll
    for (int j = 0; j < 4; ++j) { const int n = (lane >> 3) + 8 * j; const LAS float* s = scr + (8 * c) * 33 + n;
        u32x4 o; o.x = cvt_pk_bf16(s[0 * 33], s[1 * 33]); o.y = cvt_pk_bf16(s[2 * 33], s[3 * 33]); o.z = cvt_pk_bf16(s[4 * 33], s[5 * 33]); o.w = cvt_pk_bf16(s[6 * 33], s[7 * 33]);
        *(u32x4*)(WT + (size_t)(drow0 + n) * ldt + k0 + 8 * c) = o; }
    LDS_WAIT();
}
__device__ __forceinline__ void convert_layer(int l, LAS unsigned char* lds, int sw) {
    const int tid = ltid(sw), lane = tid & 63, wave = __builtin_amdgcn_readfirstlane(tid >> 6);
    LAS float* scr = (LAS float*)(lds + wave * 16384);
    const int gw = lbid() * 8 + wave, NGW = lgrid() * 8, j = l >> 1;
    bf16_t* Wr = (bf16_t*)(ARG_WS + ((l & 1) ? WS_W2 : WS_W));
    if (!(l & 1)) {
        bf16_t* Wug = Wr; bf16_t* Wv = Wr + 4 * MiB; bf16_t* Wout = Wr + 6 * MiB;
        for (int it = gw; it < 4096; it += NGW) {
            if (it < 3072) { const int kb = it / 192, nb = it % 192, n0 = 32 * nb; bf16_t* dst; int drow0;
                if (n0 < 2048) { dst = Wug; drow0 = 256 * (n0 >> 7) + (n0 & 127); }
                else if (n0 < 4096) { dst = Wv; drow0 = n0 - 2048; }
                else { const int c = n0 - 4096; dst = Wug; drow0 = 256 * (c >> 7) + 128 + (c & 127); }
                tr_item(argp(I_AWIN) + (size_t)j * 1024 * 6144, 6144, 64 * kb, n0, dst, 1024, drow0, scr, lane); }
            else { const int r = it - 3072, kb = r >> 5, nb = r & 31;
                tr_item(argp(I_AWOUT) + (size_t)j * 2048 * 1024, 1024, 64 * kb, 32 * nb, Wout, 2048, 32 * nb, scr, lane); }
        }
    } else {
        bf16_t* Wx = Wr; bf16_t* Wg = Wr + 2 * MiB; bf16_t* Wgate = Wr + 4 * MiB; bf16_t* Wout = Wr + 6 * MiB;
        for (int it = gw; it < 3584; it += NGW) {
            if (it < 2048) { const int kb = it >> 7, nb = it & 127, n0 = 32 * nb;
                tr_item(argp(I_BWIN) + (size_t)j * 1024 * 4096, 4096, 64 * kb, n0, n0 < 2048 ? Wx : Wg, 1024, n0 & 2047, scr, lane); }
            else if (it < 3072) { const int r = it - 2048, kb = r >> 5, nb = r & 31;
                tr_item(argp(I_BWOUT) + (size_t)j * 2048 * 1024, 1024, 64 * kb, 32 * nb, Wout, 2048, 32 * nb, scr, lane); }
            else { const int r = it - 3072, which = r >> 8, r2 = r & 255, h = r2 >> 5, r3 = r2 & 31, kb = r3 >> 3, nb = r3 & 7, n0 = 32 * nb;
                const float* W = argp(which ? I_BGXW : I_BGAW) + (size_t)(j * 8 + h) * 256 * 256;
                tr_item(W, 256, 64 * kb, n0, Wgate, 256, (2 * h + (n0 >> 7)) * 256 + which * 128 + (n0 & 127), scr, lane); }
        }
    }
}
__device__ __forceinline__ void mod_phase(LAS unsigned char* lds, int sw) {
    const int tid = ltid(sw), wave = tid >> 6, lane = tid & 63;
    unsigned char* ws = ARG_WS; float* mod = (float*)(ws + WS_MOD); float* nsp = (float*)(ws + WS_NSP);
    const float* lam = argp(I_BLAM); const float* cin = argp(I_C); const float* modw = argp(I_MODW); const float* modb = argp(I_MODB);
    const int bid = lbid(), nblk = lgrid();
    if (bid == nblk - 1) for (int i = tid; i < 4096; i += 512) nsp[i] = -8.0f * log1pf(expf(-lam[i]));
    LAS float* sc = (LAS float*)lds; LAS float* red = (LAS float*)(lds + 32768);
    for (int item = bid; item < 192; item += nblk) {
        __syncthreads();
        for (int i = tid; i < 8192; i += 512) { const float v = cin[i]; sc[i] = v / (1.0f + expf(-v)); }
        __syncthreads();
        const int l = item / 48, n0 = (item % 48) * 64;
        const float* W = modw + ((size_t)l * 1024 + wave * 128) * 3072 + n0 + lane;
        float acc[8];
#pragma unroll
        for (int b = 0; b < 8; ++b) acc[b] = 0.f;
        for (int k = 0; k < 128; k += 4) {
            const float w0 = ntload(W + (size_t)(k + 0) * 3072), w1 = ntload(W + (size_t)(k + 1) * 3072), w2 = ntload(W + (size_t)(k + 2) * 3072), w3 = ntload(W + (size_t)(k + 3) * 3072);
#pragma unroll
            for (int b = 0; b < 8; ++b) { const f32x4 s = *(const LAS f32x4*)(sc + b * 1024 + wave * 128 + k); acc[b] += (s[0] * w0 + s[1] * w1) + (s[2] * w2 + s[3] * w3); }
        }
#pragma unroll
        for (int b = 0; b < 8; ++b) red[(wave * 8 + b) * 64 + lane] = acc[b];
        __syncthreads();
        { const int b = wave; float s = 0.f;
#pragma unroll
          for (int w = 0; w < 8; ++w) s += red[(w * 8 + b) * 64 + lane];
          const int n = n0 + lane; mod[(size_t)(l * 8 + b) * 3072 + n] = s + modb[l * 3072 + n]; }
    }
    __syncthreads();
}

__device__ __forceinline__ void final_phase(int l, const bf16_t* OUT, int sw, View vw) {
    vw = lview(vw);
    const int tid = ltid(sw), lane = tid & 63, wave = __builtin_amdgcn_readfirstlane(tid >> 6);
    const int gw = vw.vb * 8 + wave, NGW = vw.vG * 8;
    unsigned char* ws = ARG_WS; float* xout = ARG_OUT;
    const float* xin = (l <= 0) ? argp(I_X) : (const float*)xout;
    const float* mod = (const float*)(ws + WS_MOD); const float* SSQ = (const float*)(ws + WS_SSQ);
    bf16_t* H = (bf16_t*)(ws + WS_H);
    const float* postn = argp(I_POST) + (l < 0 ? 0 : l) * D; const float* pren = argp(I_PRE) + (l + 1 < DEPTH ? l + 1 : 0) * D;
    constexpr int RB = 4;
    for (int r0 = vw.row0 + gw; r0 < vw.row0 + vw.MR; r0 += RB * NGW) {
        f32x4 v[RB][4]; u32x2 o[RB][4]; float ss[RB];
#pragma unroll
        for (int k = 0; k < RB; ++k) { const int r = r0 + k * NGW;
#pragma unroll
            for (int j = 0; j < 4; ++j) v[k][j] = ntload((const f32x4*)(xin + (size_t)r * D + 4 * lane + 256 * j));
            if (l >= 0) {
#pragma unroll
                for (int j = 0; j < 4; ++j) o[k][j] = ntload((const u32x2*)(OUT + (size_t)r * D + 4 * lane + 256 * j));
                ss[k] = (lane < 16) ? SSQ[(size_t)r * 16 + lane] : 0.f; } }
        if (l >= 0) {
            float rs[RB];
#pragma unroll
            for (int k = 0; k < RB; ++k) rs[k] = 1.0f / sqrtf(wave_sum(ss[k]) * (1.0f / D) + EPS);
#pragma unroll
            for (int j = 0; j < 4; ++j) { const int col = 4 * lane + 256 * j;
                const f32x4 p = *(const f32x4*)(postn + col); f32x4 g = (f32x4){0.f, 0.f, 0.f, 0.f}; int bprev = -1;
#pragma unroll
                for (int k = 0; k < RB; ++k) { const int r = r0 + k * NGW, b = r >> 12;
                    if (b != bprev) { g = *(const f32x4*)(mod + (size_t)(l * 8 + b) * 3072 + 2048 + col); bprev = b; }
                    const float rstd = rs[k];
                    v[k][j][0] += g[0] * (bf_lo(o[k][j].x) * rstd * p[0]); v[k][j][1] += g[1] * (bf_hi(o[k][j].x) * rstd * p[1]);
                    v[k][j][2] += g[2] * (bf_lo(o[k][j].y) * rstd * p[2]); v[k][j][3] += g[3] * (bf_hi(o[k][j].y) * rstd * p[3]);
                    __builtin_nontemporal_store(v[k][j], (f32x4*)(xout + (size_t)r * D + col)); } }
        }
        if (l + 1 < DEPTH) {
            float rs[RB];
#pragma unroll
            for (int k = 0; k < RB; ++k) { float s = 0.f;
#pragma unroll
                for (int j = 0; j < 4; ++j) s += (v[k][j][0] * v[k][j][0] + v[k][j][1] * v[k][j][1]) + (v[k][j][2] * v[k][j][2] + v[k][j][3] * v[k][j][3]);
                rs[k] = 1.0f / sqrtf(wave_sum(s) * (1.0f / D) + EPS); }
#pragma unroll
            for (int j = 0; j < 4; ++j) { const int col = 4 * lane + 256 * j;
                const f32x4 p = *(const f32x4*)(pren + col); f32x4 sh = (f32x4){0.f, 0.f, 0.f, 0.f}, sc = sh; int bprev = -1;
#pragma unroll
                for (int k = 0; k < RB; ++k) { const int r = r0 + k * NGW, b = r >> 12;
                    if (b != bprev) { const float* md = mod + (size_t)((l + 1) * 8 + b) * 3072; sh = *(const f32x4*)(md + col); sc = *(const f32x4*)(md + 1024 + col); bprev = b; }
                    float h[4];
#pragma unroll
                    for (int e = 0; e < 4; ++e) h[e] = v[k][j][e] * rs[k] * p[e] * (1.0f + sc[e]) + sh[e];
                    u32x2 w; w.x = cvt_pk_bf16(h[0], h[1]); w.y = cvt_pk_bf16(h[2], h[3]);
                    *(u32x2*)(H + (size_t)r * D + col) = w; } }
        }
    }
}

__device__ __forceinline__ void build_wp(const float* wsrc_g, LAS unsigned char* WPb, LAS float* M2b, const LAS float* MU, const LAS float* RS, int tid) {
    const int t = tid >> 2, part = tid & 3, s0 = 32 * part;
    const float* wsrc = wsrc_g + t * 128 + s0;
    float m2 = 0.f;
#pragma unroll
    for (int q = 0; q < 4; ++q) { const f32x4 w0 = *(const f32x4*)(wsrc + 8 * q), w1 = *(const f32x4*)(wsrc + 8 * q + 4);
        const float wv[8] = {w0[0], w0[1], w0[2], w0[3], w1[0], w1[1], w1[2], w1[3]};
        unsigned pk[4];
#pragma unroll
        for (int e = 0; e < 8; e += 2) { const int s = s0 + 8 * q + e;
            const float x0 = (s <= t) ? wv[e] * RS[s] : 0.f, x1 = (s + 1 <= t) ? wv[e + 1] * RS[s + 1] : 0.f;
            const unsigned p = cvt_pk_bf16(x0, x1); pk[e >> 1] = p;
            m2 += bf_lo(p) * MU[s] + bf_hi(p) * MU[s + 1]; }
        *(LAS u32x4*)(WPb + t * 272 + (s0 + 8 * q) * 2) = (u32x4){pk[0], pk[1], pk[2], pk[3]}; }
    m2 += __shfl_xor(m2, 1); m2 += __shfl_xor(m2, 2);
    if (part == 0) M2b[t] = m2;
}
__device__ __forceinline__ void spatial_phase(int j, const bf16_t* UG, bf16_t* Y, const bf16_t* Vt, LAS unsigned char* lds, int sw, View vw) {
    vw = lview(vw);
    const int tid = ltid(sw), bid = vw.vb, nblk = vw.vG;
    const int wave = __builtin_amdgcn_readfirstlane(tid >> 6), lane = tid & 63, fr = lane & 15, fq = lane >> 4;
    const f32x2* VSTAT = (const f32x2*)(ARG_WS + WS_VSTAT);
    const float* aws = argp(I_AWS) + (size_t)j * 8 * 128 * 128; const float* abs_ = argp(I_ABS) + (size_t)j * 8 * 128;
    constexpr int WPITCH = 272, WPB = 128 * WPITCH;
    LAS float* MU = (LAS float*)(lds + 2 * WPB); LAS float* RS = MU + 128; LAS float* M2 = MU + 256;
    const float* gamma = argp(I_AVN) + j * E;
    const int vrow = 8 * (fr >> 2) + (fr & 3);
    for (int chunk = (vw.row0 >> 7) + bid; chunk < ((vw.row0 + vw.MR) >> 7); chunk += nblk) {
        const int tok0 = chunk * 128;
        __syncthreads();
        if (tid < 128) { float s = 0.f, q = 0.f;
#pragma unroll
            for (int p = 0; p < 16; ++p) { const f32x2 v = VSTAT[(size_t)p * M + tok0 + tid]; s += v[0]; q += v[1]; }
            const float mu = s * (1.0f / E), var = q * (1.0f / E) - mu * mu;
            MU[tid] = mu; RS[tid] = 1.0f / sqrtf(var + EPS); }
        __syncthreads();
        build_wp(aws, lds, M2, MU, RS, tid);
        bf16x8 vf[2][4]; u32x4 ug[8];
        const unsigned vlo = (unsigned)(vrow * 128 + 8 * fq), ulo = (unsigned)(fr * E + 8 * fq);
        { const bf16_t* vp = Vt + ((size_t)chunk * E + 32 * wave) * 128;
#pragma unroll
          for (int f = 0; f < 2; ++f)
#pragma unroll
            for (int ks = 0; ks < 4; ++ks) vf[f][ks] = ntload((const bf16x8*)(vp + (4 * f) * 128 + 32 * ks + vlo)); }
        __syncthreads();
        for (int g = 0; g < 8; ++g) {
            const int buf = g & 1, ch0 = 256 * g + 32 * wave;
            const bf16_t* up = UG + (size_t)tok0 * E + ch0; bf16_t* yp = Y + (size_t)tok0 * E + ch0;
#pragma unroll
            for (int i = 0; i < 8; ++i) ug[i] = ntload((const u32x4*)(up + (size_t)(16 * i) * E + ulo));
            if (g < 7) {
                build_wp(aws + (size_t)(g + 1) * 128 * 128, lds + (buf ^ 1) * WPB, M2 + (buf ^ 1) * 128, MU, RS, tid);
            }
            const LAS unsigned char* WP = lds + buf * WPB; const LAS float* M2c = M2 + buf * 128;
            f32x4 acc[2][8];
#pragma unroll
            for (int f = 0; f < 2; ++f)
#pragma unroll
                for (int i = 0; i < 8; ++i) acc[f][i] = (f32x4){0.f, 0.f, 0.f, 0.f};
#pragma unroll
            for (int i = 0; i < 8; ++i)
#pragma unroll
                for (int ks = 0; ks <= (i >> 1); ++ks) {
                    const bf16x8 wf = *(const LAS bf16x8*)(WP + (16 * i + fr) * WPITCH + (32 * ks + 8 * fq) * 2);
#pragma unroll
                    for (int f = 0; f < 2; ++f) acc[f][i] = __builtin_amdgcn_mfma_f32_16x16x32_bf16(vf[f][ks], wf, acc[f][i], 0, 0, 0);
                }
            if (g < 7) {
                const bf16_t* vp = Vt + ((size_t)chunk * E + ch0 + 256) * 128;
#pragma unroll
                for (int f = 0; f < 2; ++f)
#pragma unroll
                    for (int ks = 0; ks < 4; ++ks) vf[f][ks] = ntload((const bf16x8*)(vp + (4 * f) * 128 + 32 * ks + vlo));
            }
            const float* bsp = abs_ + g * 128;
            const f32x4 gm0 = *(const f32x4*)(gamma + ch0 + 8 * fq), gm1 = *(const f32x4*)(gamma + ch0 + 8 * fq + 4);
#pragma unroll
            for (int i = 0; i < 8; ++i) { const int t = 16 * i + fr; const float m2 = M2c[t], bs = bsp[t];
                const u32x4 u4 = ug[i];
                const float y0 = bf_lo(u4.x) * (gm0[0] * (acc[0][i][0] - m2) + bs), y1 = bf_hi(u4.x) * (gm0[1] * (acc[0][i][1] - m2) + bs);
                const float y2 = bf_lo(u4.y) * (gm0[2] * (acc[0][i][2] - m2) + bs), y3 = bf_hi(u4.y) * (gm0[3] * (acc[0][i][3] - m2) + bs);
                const float y4 = bf_lo(u4.z) * (gm1[0] * (acc[1][i][0] - m2) + bs), y5 = bf_hi(u4.z) * (gm1[1] * (acc[1][i][1] - m2) + bs);
                const float y6 = bf_lo(u4.w) * (gm1[2] * (acc[1][i][2] - m2) + bs), y7 = bf_hi(u4.w) * (gm1[3] * (acc[1][i][3] - m2) + bs);
                u32x4 w; w.x = cvt_pk_bf16(y0, y1); w.y = cvt_pk_bf16(y2, y3); w.z = cvt_pk_bf16(y4, y5); w.w = cvt_pk_bf16(y6, y7);
                *(u32x4*)(yp + (size_t)(16 * i) * E + ulo) = w; }
            __syncthreads();
        }
    }
    __syncthreads();
}

__device__ __forceinline__ void conv_edge_phase(int j, const bf16_t* XBE, bf16_t* XC, int sw, View vw) {
    vw = lview(vw);
    const int tid = ltid(sw), gtid = vw.vb * 512 + tid, NT = vw.vG * 512;
    const float* cw = argp(I_BCW) + (size_t)j * 4 * E; const float* cb = argp(I_BCB) + (size_t)j * E;
    for (int idx = gtid; idx < (vw.MR / 64) * 256; idx += NT) {
        const int slab = (vw.row0 >> 6) + (idx >> 8), o = idx & 255, c0 = 8 * o, r0 = slab * 64;
        float w[4][8], bias[8];
#pragma unroll
        for (int k = 0; k < 4; ++k) { const f32x4 t0 = *(const f32x4*)(cw + k * E + c0), t1 = *(const f32x4*)(cw + k * E + c0 + 4);
#pragma unroll
            for (int e = 0; e < 4; ++e) { w[k][e] = t0[e]; w[k][4 + e] = t1[e]; } }
        { const f32x4 t0 = *(const f32x4*)(cb + c0), t1 = *(const f32x4*)(cb + c0 + 4);
#pragma unroll
          for (int e = 0; e < 4; ++e) { bias[e] = t0[e]; bias[4 + e] = t1[e]; } }
        const bool head = ((r0 & (SEQ - 1)) == 0);
        u32x4 p[6];
        const bf16_t* xb = XBE + (size_t)r0 * E + c0;
#pragma unroll
        for (int i = 0; i < 3; ++i) p[i] = head ? (u32x4){0u, 0u, 0u, 0u} : *(const u32x4*)(xb + (ptrdiff_t)(i - 3) * E);
#pragma unroll
        for (int i = 0; i < 3; ++i) p[3 + i] = *(const u32x4*)(xb + (size_t)i * E);
        bf16_t* xc = XC + (size_t)r0 * E + c0;
#pragma unroll
        for (int tt = 0; tt < 3; ++tt) {
            float y[8];
#pragma unroll
            for (int e = 0; e < 4; ++e) {
                y[2 * e]     = bias[2 * e]     + w[0][2 * e]     * bf_lo(p[tt][e]) + w[1][2 * e]     * bf_lo(p[tt + 1][e]) + w[2][2 * e]     * bf_lo(p[tt + 2][e]) + w[3][2 * e]     * bf_lo(p[tt + 3][e]);
                y[2 * e + 1] = bias[2 * e + 1] + w[0][2 * e + 1] * bf_hi(p[tt][e]) + w[1][2 * e + 1] * bf_hi(p[tt + 1][e]) + w[2][2 * e + 1] * bf_hi(p[tt + 2][e]) + w[3][2 * e + 1] * bf_hi(p[tt + 3][e]); }
            u32x4 o4; o4.x = cvt_pk_bf16(y[0], y[1]); o4.y = cvt_pk_bf16(y[2], y[3]); o4.z = cvt_pk_bf16(y[4], y[5]); o4.w = cvt_pk_bf16(y[6], y[7]);
            *(u32x4*)(xc + (size_t)tt * E) = o4;
        }
    }
}

__device__ __forceinline__ void scan1_phase(const bf16_t* LA, const bf16_t* BT, int sw, View vw) {
    vw = lview(vw);
    const int tid = ltid(sw), gtid = vw.vb * 512 + tid, NT = vw.vG * 512;
    unsigned char* ws = ARG_WS; float* CP = (float*)(ws + WS_CP); float* CH = (float*)(ws + WS_CH);
    for (int idx = gtid; idx < (vw.MR >> 6) * 512; idx += NT) {
        const int quad = idx & 511, bq = (vw.row0 >> 6) + (idx >> 9);
        const size_t base = (size_t)bq * 64 * E + 4 * quad;
        float S[4] = {0.f, 0.f, 0.f, 0.f}, Hc[4] = {0.f, 0.f, 0.f, 0.f};
#pragma unroll 1
        for (int tb = 0; tb < 64; tb += 16) {
            u32x2 lw[16], bw[16];
#pragma unroll
            for (int i = 0; i < 16; ++i) { lw[i] = *(const u32x2*)(LA + base + (size_t)(tb + i) * E); bw[i] = *(const u32x2*)(BT + base + (size_t)(tb + i) * E); }
#pragma unroll
            for (int i = 0; i < 16; ++i) {
                const float l0 = bf_lo(lw[i].x), l1 = bf_hi(lw[i].x), l2 = bf_lo(lw[i].y), l3 = bf_hi(lw[i].y);
                S[0] += l0; S[1] += l1; S[2] += l2; S[3] += l3;
                Hc[0] = fexp(l0) * Hc[0] + bf_lo(bw[i].x); Hc[1] = fexp(l1) * Hc[1] + bf_hi(bw[i].x); Hc[2] = fexp(l2) * Hc[2] + bf_lo(bw[i].y); Hc[3] = fexp(l3) * Hc[3] + bf_hi(bw[i].y); }
        }
        *(f32x4*)(CP + (size_t)bq * E + 4 * quad) = (f32x4){S[0], S[1], S[2], S[3]};
        *(f32x4*)(CH + (size_t)bq * E + 4 * quad) = (f32x4){Hc[0], Hc[1], Hc[2], Hc[3]};
    }
}
__device__ __forceinline__ void scan2_phase(const bf16_t* LA, const bf16_t* BT, bf16_t* GS, int sw, View vw) {
    vw = lview(vw);
    const int tid = ltid(sw), gtid = vw.vb * 512 + tid, NT = vw.vG * 512;
    unsigned char* ws = ARG_WS; const float* CP = (const float*)(ws + WS_CP); const float* CH = (const float*)(ws + WS_CH);
    for (int idx = gtid; idx < (vw.MR >> 6) * 512; idx += NT) {
        const int quad = idx & 511, bq = (vw.row0 >> 6) + (idx >> 9), q = bq & 63, b = bq >> 6;
        const size_t base = (size_t)bq * 64 * E + 4 * quad;
        u32x2 lw[8], bw[8], gw[8];
#pragma unroll
        for (int i = 0; i < 8; ++i) { lw[i] = ntload((const u32x2*)(LA + base + (size_t)i * E)); bw[i] = ntload((const u32x2*)(BT + base + (size_t)i * E)); gw[i] = ntload((const u32x2*)(GS + base + (size_t)i * E)); }
        float h[4] = {0.f, 0.f, 0.f, 0.f};
        const float* cp = CP + (size_t)(b * 64) * E + 4 * quad; const float* chp = CH + (size_t)(b * 64) * E + 4 * quad;
        int qq = 0;
        for (; qq + 8 <= q; qq += 8) {
            f32x4 P[8], Hq[8];
#pragma unroll
            for (int i = 0; i < 8; ++i) { P[i] = *(const f32x4*)(cp + (size_t)(qq + i) * E); Hq[i] = *(const f32x4*)(chp + (size_t)(qq + i) * E); }
#pragma unroll
            for (int i = 0; i < 8; ++i)
#pragma unroll
                for (int e = 0; e < 4; ++e) h[e] = fexp(P[i][e]) * h[e] + Hq[i][e];
        }
        for (; qq < q; ++qq) { const f32x4 P = *(const f32x4*)(cp + (size_t)qq * E), Hq = *(const f32x4*)(chp + (size_t)qq * E);
#pragma unroll
            for (int e = 0; e < 4; ++e) h[e] = fexp(P[e]) * h[e] + Hq[e]; }
#pragma unroll 1
        for (int tb = 0; tb < 64; tb += 8) {
            u32x2 lwn[8], bwn[8], gwn[8];
            if (tb + 8 < 64) {
#pragma unroll
                for (int i = 0; i < 8; ++i) { lwn[i] = ntload((const u32x2*)(LA + base + (size_t)(tb + 8 + i) * E)); bwn[i] = ntload((const u32x2*)(BT + base + (size_t)(tb + 8 + i) * E)); gwn[i] = ntload((const u32x2*)(GS + base + (size_t)(tb + 8 + i) * E)); }
            }
            u32x2 w[8];
#pragma unroll
            for (int i = 0; i < 8; ++i) {
                h[0] = fexp(bf_lo(lw[i].x)) * h[0] + bf_lo(bw[i].x); h[1] = fexp(bf_hi(lw[i].x)) * h[1] + bf_hi(bw[i].x);
                h[2] = fexp(bf_lo(lw[i].y)) * h[2] + bf_lo(bw[i].y); h[3] = fexp(bf_hi(lw[i].y)) * h[3] + bf_hi(bw[i].y);
                w[i].x = cvt_pk_bf16(h[0] * fsilu(bf_lo(gw[i].x)), h[1] * fsilu(bf_hi(gw[i].x))); w[i].y = cvt_pk_bf16(h[2] * fsilu(bf_lo(gw[i].y)), h[3] * fsilu(bf_hi(gw[i].y))); }
#pragma unroll
            for (int i = 0; i < 8; ++i) *(u32x2*)(GS + base + (size_t)(tb + i) * E) = w[i];
            if (tb + 8 < 64) {
#pragma unroll
                for (int i = 0; i < 8; ++i) { lw[i] = lwn[i]; bw[i] = bwn[i]; gw[i] = gwn[i]; }
            }
        }
    }
}

__global__ void __launch_bounds__(512, 2) mega_fwd(Args a) {
    LAS unsigned char* lds = (LAS unsigned char*)lds_raw;
    volatile LAS unsigned* ctlw = (volatile LAS unsigned*)(lds + LDS_CTL_OFF);
    const int sw = __builtin_amdgcn_readfirstlane((int)threadIdx.x >> 6);
    { const int tid = threadIdx.x;
      if (tid < 64) ctlw[tid] = 0u;
      __syncthreads();
      const XcdBarrier b0 = xcd_barrier_post((unsigned*)(ARG_WS + WS_CTL), ctlw + 8);
      if (tid == 0) ctlw[10] = b0.x;
      __syncthreads(); }
#define BAR_(loc) do { XcdBarrier bb_; bb_.bar = (unsigned*)(ARG_WS + WS_CTL); bb_.st = ctlw + 8; bb_.x = ctlw[10]; xcd_barrier(bb_, (loc)); } while (0)
#define GRID_BAR() BAR_(0)
#define SEAM_BAR() BAR_((int)ctlw[12])
#define WSB(off) ((bf16_t*)(ARG_WS + (off)))
#define WSW(eoff) ((bf16_t*)(ARG_WS + ((l & 1) ? WS_W2 : WS_W)) + (eoff))
#define VIEW() (ctlw[12] ? View{(int)__builtin_amdgcn_readfirstlane((int)ctlw[11]), 32, (int)__builtin_amdgcn_readfirstlane((int)ctlw[10]) * (M / 8), M / 8} : View{lbid(), lgrid(), 0, M})

    mod_phase(lds, sw);
    convert_layer(0, lds, sw);
    if (__hip_atomic_load((unsigned*)(ARG_WS + WS_CTL) + 64, __ATOMIC_RELAXED, __HIP_MEMORY_SCOPE_AGENT) == 0xffffffffu) cg::this_grid().sync();
    GRID_BAR();
    if (threadIdx.x == 0) { unsigned* bar_ = (unsigned*)(ARG_WS + WS_CTL); unsigned ok = (lgrid() == 256) ? 1u : 0u;
        for (unsigned j_ = 0; j_ < 16; ++j_) ok &= (xb_ld(&bar_[XB_XCNT(j_)]) == (j_ < 8u ? 32u : 0u)) ? 1u : 0u;
        ok &= (ctlw[10] < 8u && ctlw[11] < 32u) ? 1u : 0u;
        ctlw[12] = ok; }
    __syncthreads();
    final_phase(-1, nullptr, sw, VIEW());
    SEAM_BAR();

    for (int l = 0; l < DEPTH; ++l) {
        const int j = l >> 1;
        if (!(l & 1)) {
            { const View vw = VIEW(); const size_t ro = (size_t)vw.row0;
              { pg8::Gemm g{WSB(WS_H) + ro * D, WSW(0), D, D, D, 0}; pg8::StaticOrder S; S.init(vw.MR / 256, 4096 / 256, vw.vG, vw.vb);
                pg8::EpiUG Ep{WSB(WS_R1) + ro * E}; pg8::gemm_phase(lds, g, S, Ep, sw); }
              { pg8::Gemm g{WSW(4 * MiB), WSB(WS_H) + ro * D, D, D, D, 0}; pg8::StaticOrder S; S.init(E / 256, vw.MR / 256, vw.vG, vw.vb);
                pg8::EpiVt Ep{WSB(WS_R3) + ro * E, (f32x2*)(ARG_WS + WS_VSTAT) + ro}; pg8::gemm_phase(lds, g, S, Ep, sw); } }
            SEAM_BAR();
            spatial_phase(j, WSB(WS_R1), WSB(WS_R4), WSB(WS_R3), lds, sw, VIEW());
            SEAM_BAR();
            { const View vw = VIEW(); const size_t ro = (size_t)vw.row0;
              pg8::Gemm g{WSB(WS_R4) + ro * E, WSW(6 * MiB), E, E, E, 0}; pg8::StaticOrder S; S.init(vw.MR / 256, D / 256, vw.vG, vw.vb);
              pg8::EpiOut Ep{WSB(WS_R1) + ro * E, (float*)(ARG_WS + WS_SSQ) + ro * 16}; pg8::gemm_phase(lds, g, S, Ep, sw); }
        } else {
            { const View vw = VIEW(); const size_t ro = (size_t)vw.row0;
              pg8::Gemm g{WSB(WS_H) + ro * D, WSW(0), D, D, D, 0}; pg8::StaticOrder S; S.init(vw.MR / 256, E / 256, vw.vG, vw.vb); S.sticky = 1;
              LAS float* cl = (LAS float*)(lds + LDS_GB_OFF);
              { const float* cw = argp(I_BCW) + (size_t)j * 4 * E + (vw.vb % (E / 256)) * 256; const float* cb = argp(I_BCB) + (size_t)j * E + (vw.vb % (E / 256)) * 256; const int t_ = ltid(sw);
                if (t_ < 320) { const int k_ = t_ >> 6, q_ = t_ & 63; *(LAS f32x4*)(cl + k_ * 256 + 4 * q_) = *(const f32x4*)((k_ < 4 ? cw + k_ * E : cb) + 4 * q_); }
                __syncthreads(); }
              pg8::EpiConv Ep{WSB(WS_R3) + ro * E, WSB(WS_R1) + ro * E, cl}; pg8::gemm_phase(lds, g, S, Ep, sw); }
            SEAM_BAR();
            conv_edge_phase(j, WSB(WS_R1), WSB(WS_R3), sw, VIEW());
            SEAM_BAR();
            { const View vw = VIEW(); const size_t ro = (size_t)vw.row0;
              pg8::Gemm g{WSB(WS_R3) + ro * E, WSW(4 * MiB), E, 256, 256, 256}; pg8::StaticOrder S; S.init(vw.MR / 256, 16, vw.vG, vw.vb);
              LAS float* gbl = (LAS float*)(lds + LDS_GB_OFF);
              { const float* s0 = argp(I_BGAB) + j * E; const float* s1 = argp(I_BGXB) + j * E; const float* s2 = (const float*)(ARG_WS + WS_NSP) + j * E; const int t_ = ltid(sw);
                for (int i_ = t_; i_ < E / 4; i_ += 512) { *(LAS f32x4*)(gbl + 4 * i_) = *(const f32x4*)(s0 + 4 * i_); *(LAS f32x4*)(gbl + E + 4 * i_) = *(const f32x4*)(s1 + 4 * i_); *(LAS f32x4*)(gbl + 2 * E + 4 * i_) = *(const f32x4*)(s2 + 4 * i_); }
                __syncthreads(); }
              pg8::EpiGate Ep{WSB(WS_R3) + ro * E, WSB(WS_R1) + ro * E, WSB(WS_R4) + ro * E, gbl, gbl + E, gbl + 2 * E}; pg8::gemm_phase(lds, g, S, Ep, sw); }
            SEAM_BAR();
            { int nst_ = 2; asm volatile("" : "+s"(nst_));
              for (int st_ = 0; st_ < nst_; ++st_) {
                const View vw = VIEW(); const size_t ro = (size_t)vw.row0;
                if (st_ == 0) scan1_phase(WSB(WS_R1), WSB(WS_R4), sw, vw);
                else { pg8::Gemm g{WSB(WS_H) + ro * D, WSW(2 * MiB), D, D, D, 0}; pg8::StaticOrder S; S.init(vw.MR / 256, E / 256, vw.vG, vw.vb);
                       pg8::EpiPlain<0> Ep{WSB(WS_R3) + ro * E, E}; pg8::gemm_phase(lds, g, S, Ep, sw); } } }
            SEAM_BAR();
            scan2_phase(WSB(WS_R1), WSB(WS_R4), WSB(WS_R3), sw, VIEW());
            SEAM_BAR();
            { const View vw = VIEW(); const size_t ro = (size_t)vw.row0;
              pg8::Gemm g{WSB(WS_R3) + ro * E, WSW(6 * MiB), E, E, E, 0}; pg8::StaticOrder S; S.init(vw.MR / 256, D / 256, vw.vG, vw.vb);
              pg8::EpiOut Ep{WSB(WS_R1) + ro * E, (float*)(ARG_WS + WS_SSQ) + ro * 16}; pg8::gemm_phase(lds, g, S, Ep, sw); }
        }
        SEAM_BAR();
        { const View vw = VIEW(); final_phase(l, WSB(WS_R1) + (size_t)vw.row0 * (E - D), sw, vw); }
        if (l + 1 < DEPTH) { convert_layer(l + 1, lds, sw); GRID_BAR(); }
    }
}

extern "C" void kernel_launch(void* const* d_in, const int* in_sizes, int n_in, void* d_out, int out_size, void* d_ws, size_t ws_size, hipStream_t stream) {
    static int grid = 0;
    if (grid == 0) {
        if (n_in != 20 || in_sizes[0] != M * D || out_size != M * D || ws_size < WS_END) { fprintf(stderr, "kernel_launch: unexpected shapes (n_in %d, in0 %d, out %d, ws %zu < %zu); nothing launched\n", n_in, n_in > 0 ? in_sizes[0] : -1, out_size, ws_size, (size_t)WS_END); grid = -1; return; }
        int dev = 0, cus = 0, per_cu = 0;
        if (hipGetDevice(&dev) != hipSuccess || hipDeviceGetAttribute(&cus, hipDeviceAttributeMultiprocessorCount, dev) != hipSuccess) { grid = -1; return; }
        if (hipFuncSetAttribute((const void*)mega_fwd, hipFuncAttributeMaxDynamicSharedMemorySize, LDS_BYTES) != hipSuccess) { fprintf(stderr, "kernel_launch: hipFuncSetAttribute failed\n"); grid = -1; return; }
        if (hipOccupancyMaxActiveBlocksPerMultiprocessor(&per_cu, (const void*)mega_fwd, 512, LDS_BYTES) != hipSuccess || per_cu < 1) { fprintf(stderr, "kernel_launch: occupancy query says %d blocks per CU\n", per_cu); per_cu = 1; }
        (void)hipGetLastError();
        grid = cus;
        if (grid != 256) { fprintf(stderr, "kernel_launch: built for a 256-CU device (scan phases map one workgroup to (batch, 64 channels)); found %d CUs; nothing launched\n", cus); grid = -1; return; }
    }
    if (grid < 0) return;
    (void)hipMemsetAsync((char*)d_ws + WS_CTL, 0, CTL_ZERO_BYTES, stream);
    Args a{};
    for (int i = 0; i < 20; ++i) a.in[i] = (const float*)d_in[i];
    a.out = (float*)d_out; a.ws = (unsigned char*)d_ws;
    void* args[] = {&a};
    const hipError_t e = hipLaunchCooperativeKernel((const void*)mega_fwd, dim3(grid), dim3(512), args, LDS_BYTES, stream);
    if (e != hipSuccess) fprintf(stderr, "kernel_launch: cooperative launch failed: %s (grid %d)\n", hipGetErrorString(e), grid);
}
```

```cpp
#include <hip/hip_runtime.h>
#include <hip/hip_cooperative_groups.h>
#include <cstdio>
namespace cg = cooperative_groups;

#define LAS __attribute__((address_space(3)))
typedef unsigned short bf16_t;
typedef short bf16x8 __attribute__((ext_vector_type(8)));
typedef float f32x4 __attribute__((ext_vector_type(4)));
typedef float f32x2 __attribute__((ext_vector_type(2)));
typedef unsigned u32x4 __attribute__((ext_vector_type(4)));
typedef unsigned u32x2 __attribute__((ext_vector_type(2)));

constexpr int D = 1024, NB = 8, SEQ = 4096, M = NB * SEQ, E = 2048, DEPTH = 4;
constexpr float EPS = 1e-6f;
constexpr size_t MiB = 1u << 20;
constexpr size_t WS_CTL = 0, CTL_ZERO_BYTES = 65536;
constexpr size_t WS_MOD = 1 * MiB;
constexpr size_t WS_NSP = 1 * MiB + 512 * 1024;
constexpr size_t WS_VSTAT = 2 * MiB;
constexpr size_t WS_SSQ = 6 * MiB;
constexpr size_t WS_CP = 8 * MiB, WS_CH = 12 * MiB;
constexpr size_t WS_W = 16 * MiB;
constexpr size_t WS_H = 32 * MiB;
constexpr size_t WS_R1 = 96 * MiB, WS_R3 = 224 * MiB, WS_R4 = 352 * MiB, WS_W2 = 480 * MiB, WS_END = 496 * MiB;
constexpr int LDS_BYTES = 156672, LDS_CTL_OFF = 131072, LDS_GB_OFF = LDS_CTL_OFF + 1024;

__device__ __forceinline__ unsigned cvt_pk_bf16(float lo, float hi) { unsigned r; asm volatile("v_cvt_pk_bf16_f32 %0, %1, %2" : "=v"(r) : "v"(lo), "v"(hi)); return r; }
__device__ __forceinline__ float bf_lo(unsigned w) { return __uint_as_float(w << 16); }
__device__ __forceinline__ float bf_hi(unsigned w) { return __uint_as_float(w & 0xffff0000u); }
__device__ __forceinline__ float fsigmoid(float x) { return __builtin_amdgcn_rcpf(1.0f + __builtin_amdgcn_exp2f(-1.44269504f * x)); }
__device__ __forceinline__ float fsilu(float x) { return x * fsigmoid(x); }
__device__ __forceinline__ float fgelu(float x) { const float u = x * (1.0f + 0.044715f * x * x); return x * fsigmoid(1.59576912f * u); }
__device__ __forceinline__ float fexp(float x) { return __builtin_amdgcn_exp2f(1.44269504f * x); }
__device__ __forceinline__ float wave_sum(float v) {
#pragma unroll
    for (int o = 1; o < 64; o <<= 1) v += __shfl_xor(v, o);
    return v;
}
#define LDS_WAIT() asm volatile("s_waitcnt lgkmcnt(0)" ::: "memory")
template <class T> __device__ __forceinline__ T ntload(const T* p) { return __builtin_nontemporal_load(p); }
__device__ __forceinline__ int ltid(int sw) { unsigned z = 0u; asm volatile("" : "+s"(sw), "+s"(z)); int t = sw * 64 + (int)__builtin_amdgcn_mbcnt_hi(~0u, __builtin_amdgcn_mbcnt_lo(~0u, z)); asm volatile("" : "+v"(t)); return t; }
__device__ __forceinline__ int lbid() { int t = blockIdx.x; asm volatile("" : "+s"(t)); return t; }
__device__ __forceinline__ int lgrid() { int t = gridDim.x; asm volatile("" : "+s"(t)); return t; }
struct View { int vb, vG, row0, MR; };
__device__ __forceinline__ View lview(View v) { asm volatile("" : "+s"(v.vb), "+s"(v.vG), "+s"(v.row0), "+s"(v.MR)); return v; }

#define XB_TMO      128
#define XB_XCNT(j)  (256  + 64 * (j))
#define XB_XSUB(j)  (1280 + 64 * (j))
#define XB_XGEN(j)  (2304 + 64 * (j))
#define XB_TOP      3328
#define XB_TOPGEN   3392
#define XCD_BAR_WORDS 3456
#define XB_SPIN_CAP (1u << 20)
__device__ __forceinline__ unsigned xb_ld(unsigned* p)              { return __hip_atomic_load(p, __ATOMIC_RELAXED, __HIP_MEMORY_SCOPE_AGENT); }
__device__ __forceinline__ unsigned xb_add(unsigned* p, unsigned v) { return __hip_atomic_fetch_add(p, v, __ATOMIC_RELAXED, __HIP_MEMORY_SCOPE_AGENT); }
__device__ __forceinline__ unsigned xb_xcc_id() { return (unsigned)__builtin_amdgcn_s_getreg((3 << 11) | 20) & 0xFu; }
#define XB_SPIN(cond, bar) do { unsigned _sp = 0; while (cond) { __builtin_amdgcn_s_sleep(1); \
    if ((++_sp & 255u) == 0u) { if (xb_ld(&(bar)[XB_TMO])) break; if (_sp > XB_SPIN_CAP) { atomicAdd(&(bar)[XB_TMO], 1u); break; } } } } while (0)
struct XcdBarrier { unsigned* bar; unsigned x; volatile LAS unsigned* st; };
__device__ __forceinline__ XcdBarrier xcd_barrier_post(unsigned* bar, volatile LAS unsigned* st) {
    XcdBarrier b; b.bar = bar; b.x = xb_xcc_id(); b.st = st;
    if (threadIdx.x == 0) st[3] = xb_add(&bar[XB_XCNT(b.x)], 1u);
    return b;
}
__device__ __forceinline__ void xcd_barrier_complete(unsigned* bar, unsigned x, unsigned& nloc, unsigned& nx) {
    const unsigned G = gridDim.x * gridDim.y * gridDim.z;
    unsigned sum, cnt, mine, sp = 0u;
    for (;;) {
        sum = 0u; cnt = 0u; mine = 0u;
#pragma unroll
        for (unsigned j = 0; j < 16; ++j) { const unsigned c = xb_ld(&bar[XB_XCNT(j)]); sum += c; cnt += (c > 0u) ? 1u : 0u; mine = (j == x) ? c : mine; }
        if (sum == G) break;
        __builtin_amdgcn_s_sleep(1);
        if ((++sp & 255u) == 0u) { if (xb_ld(&bar[XB_TMO])) break; if (sp > XB_SPIN_CAP) { atomicAdd(&bar[XB_TMO], 1u); break; } }
    }
    nloc = mine > 0u ? mine : 1u; nx = cnt > 0u ? cnt : 1u;
}
__device__ __forceinline__ void xcd_barrier(const XcdBarrier& b, int local) {
    asm volatile("s_waitcnt vmcnt(0)" ::: "memory");
    __syncthreads();
    if (threadIdx.x == 0) {
        unsigned* bar = b.bar;
        __builtin_amdgcn_s_waitcnt(0);
        unsigned nloc = b.st[0], nx = b.st[1];
        if (nloc == 0u) { xcd_barrier_complete(bar, b.x, nloc, nx); b.st[0] = nloc; b.st[1] = nx; }
        const unsigned old = xb_add(&bar[XB_XSUB(b.x)], 1u);
        const unsigned gen = old / nloc;
        if (old + 1u == (gen + 1u) * nloc) {
            if (!local) {
            __builtin_amdgcn_fence(__ATOMIC_RELEASE, "agent");
            asm volatile("s_waitcnt vmcnt(0)" ::: "memory");
            const unsigned og = xb_add(&bar[XB_TOP], 1u);
            const unsigned tg = og / nx;
            if (og + 1u == (tg + 1u) * nx) xb_add(&bar[XB_TOPGEN], 1u);
            else XB_SPIN(xb_ld(&bar[XB_TOPGEN]) == tg, bar);
            }
            __builtin_amdgcn_fence(__ATOMIC_ACQUIRE, "agent");
            xb_add(&bar[XB_XGEN(b.x)], 1u);
            asm volatile("s_waitcnt vmcnt(0)" ::: "memory");
        } else {
            XB_SPIN(xb_ld(&bar[XB_XGEN(b.x)]) == gen, bar);
            __builtin_amdgcn_fence(__ATOMIC_ACQUIRE, "agent");
            asm volatile("s_waitcnt vmcnt(0)" ::: "memory");
        }
    }
    __syncthreads();
}

namespace pg8 {
constexpr int BM = 256, BK = 64, HALF = 128, HTB = HALF * BK * 2, STAGE_BYTES = 8 * HTB, NXCD = 8, WGM = 8;
__device__ __forceinline__ int lds_byte(int r, int c) { const int st = (r >> 4) * 2 + (c >> 5), rr = r & 15, cc = c & 31, ob = rr * 64 + cc * 2; return st * 1024 + (ob ^ (((ob >> 9) & 1) << 5)); }
__device__ __forceinline__ void stage_rc(int b, int& R, int& C) { const int st = b / 1024, sb = b % 1024, swz = sb ^ (((sb >> 9) & 1) << 5); R = (st >> 1) * 16 + swz / 64; C = (st & 1) * 32 + (swz % 64) / 2; }
__device__ __forceinline__ int perm32(int rho) { const int n = rho >> 4, i = rho & 15; return 8 * (i >> 2) + 4 * n + (i & 3); }

struct Unit { int pm, pn; };
struct Gemm { const bf16_t* A; const bf16_t* Bt; int lda, ldb, K, acol; };
struct StaticOrder {
    int nM, nN, nwg, G, c, sticky;
    __device__ void init(int nM_, int nN_, int G_, int c_) { nM = nM_; nN = nN_; nwg = nM * nN; G = G_; c = c_; sticky = 0; }
    __device__ bool next(int i, Unit& u) const {
        if (sticky) { u.pn = c % nN; u.pm = c / nN + i * (G / nN); return u.pm < nM; }
        const long L = (long)i * G + c; if (L >= nwg) return false;
        int wgid = (int)L; { const int q = nwg / NXCD, r = nwg % NXCD, xcd = wgid % NXCD, off = wgid / NXCD; wgid = (xcd < r ? xcd * (q + 1) : r * (q + 1) + (xcd - r) * q) + off; }
        const int nig = WGM * nN, gid = wgid / nig, fm = gid * WGM, gsz = (nM - fm) < WGM ? (nM - fm) : WGM;
        u.pm = fm + ((wgid % nig) % gsz); u.pn = (wgid % nig) / gsz; return true;
    }
};

template <class Epi>
__device__ __forceinline__ void gemm_phase(LAS unsigned char* lds, const Gemm g, const StaticOrder& S_in, const Epi& E, int sw) {
    StaticOrder S = S_in; asm volatile("" : "+s"(S.c), "+s"(S.G));
    const int tid = ltid(sw);
    const int wid = __builtin_amdgcn_readfirstlane(tid >> 6), lane = tid & 63, wr = wid >> 2, wc = wid & 3, fr = lane & 15, fq = lane >> 4;
    const int K = g.K, nt = K / BK;
    unsigned voffA[2], voffB[2];
#pragma unroll
    for (int i = 0; i < 2; ++i) { int R, C; stage_rc(tid * 16 + i * 8192, R, C); const int Rb = (R & ~31) + perm32(R & 31);
        voffA[i] = (unsigned)(R * g.lda + C) * 2u; voffB[i] = (unsigned)(Rb * g.ldb + C) * 2u; }
    const size_t kstep = (size_t)(BK * 2);
    const size_t hstepA = (size_t)HALF * g.lda * 2, hstepB = (size_t)HALF * g.ldb * 2;
    const unsigned ldsw = (unsigned)wid * 1024u;
    const int aoff = lds_byte(wr * 64 + fr, fq * 8), boff = lds_byte(wc * 32 + fr, fq * 8);
#define PG8_SA(b, h) (((b) * 2 + (h)) * HTB)
#define PG8_SB(b, h) ((4 + (b) * 2 + (h)) * HTB)
#define PG8_STAGE(bufoff, gbase, voff) do { _Pragma("unroll") for (int _i = 0; _i < 2; ++_i) \
        __builtin_amdgcn_global_load_lds((const __attribute__((address_space(1))) unsigned*)((const char*)(gbase) + (voff)[_i]), (LAS unsigned*)(lds + (bufoff) + ldsw + _i * 8192), 16, 0, 0); } while (0)
#define PG8_LDA(dst, b, h) do { _Pragma("unroll") for (int m = 0; m < 4; ++m) _Pragma("unroll") for (int k = 0; k < 2; ++k) dst[m][k] = *(const LAS bf16x8*)(lds + PG8_SA(b, h) + aoff + m * 2048 + k * 1024); } while (0)
#define PG8_LDB(dst, b, h) do { _Pragma("unroll") for (int n = 0; n < 2; ++n) _Pragma("unroll") for (int k = 0; k < 2; ++k) dst[n][k] = *(const LAS bf16x8*)(lds + PG8_SB(b, h) + boff + n * 2048 + k * 1024); } while (0)
#define PG8_MMA(ai, bj, At, Bt) do { __builtin_amdgcn_s_setprio(1); _Pragma("unroll") for (int m = 0; m < 4; ++m) _Pragma("unroll") for (int n = 0; n < 2; ++n) _Pragma("unroll") for (int k = 0; k < 2; ++k) \
        acc[ai][bj][m][n] = __builtin_amdgcn_mfma_f32_16x16x32_bf16(Bt[n][k], At[m][k], acc[ai][bj][m][n], 0, 0, 0); __builtin_amdgcn_s_setprio(0); } while (0)
#define PG8_WAIT_V(n) asm volatile("s_waitcnt vmcnt(" #n ")" ::: "memory")
#define PG8_WAIT_L(n) asm volatile("s_waitcnt lgkmcnt(" #n ")" ::: "memory")
#define PG8_BAR __builtin_amdgcn_s_barrier()
#define PG8_SCHED __builtin_amdgcn_sched_barrier(0)
#define PG8_ABASE(u) ((const char*)g.A + ((size_t)(u).pm * BM * g.lda + (size_t)((u).pn >> 1) * g.acol) * 2)
#define PG8_BBASE(u) ((const char*)g.Bt + (size_t)(u).pn * BM * g.ldb * 2)
    Unit cur, nxt; int ui = 0;
    if (!S.next(0, cur)) return;
    f32x4 acc[2][2][4][2];
    E.init(acc, cur, sw);
    bf16x8 At[4][2], B0[2][2], B1[2][2];
    const char* cA = PG8_ABASE(cur); const char* cB = PG8_BBASE(cur);
    PG8_STAGE(PG8_SB(0, 0), cB, voffB); PG8_STAGE(PG8_SA(0, 0), cA, voffA); PG8_STAGE(PG8_SB(0, 1), cB + hstepB, voffB); PG8_STAGE(PG8_SA(0, 1), cA + hstepA, voffA);
    if (wr == 1) PG8_BAR;
    PG8_WAIT_V(4); PG8_BAR;
    PG8_STAGE(PG8_SB(1, 0), cB + kstep, voffB); PG8_STAGE(PG8_SA(1, 0), cA + kstep, voffA); PG8_STAGE(PG8_SB(1, 1), cB + hstepB + kstep, voffB);
    PG8_WAIT_V(6); PG8_BAR;
    for (;;) {
        const bool has_next = S.next(ui + 1, nxt);
        const char* nA = has_next ? PG8_ABASE(nxt) : cA; const char* nB = has_next ? PG8_BBASE(nxt) : cB;
        for (int t = 0; t < nt; t += 2) {
            const bool last = (t == nt - 2);
            const char* a1 = cA + (size_t)(t + 1) * kstep;
            const char* a2 = last ? nA : cA + (size_t)(t + 2) * kstep; const char* b2 = last ? nB : cB + (size_t)(t + 2) * kstep;
            const char* a3 = a2 + kstep; const char* b3 = b2 + kstep;
            PG8_LDB(B0, 0, 0); PG8_SCHED; PG8_LDA(At, 0, 0); PG8_STAGE(PG8_SA(1, 1), a1 + hstepA, voffA);
            PG8_WAIT_L(8); PG8_BAR; PG8_WAIT_L(0); PG8_MMA(0, 0, At, B0); PG8_BAR; PG8_SCHED;
            PG8_LDB(B1, 0, 1); PG8_STAGE(PG8_SB(0, 0), b2, voffB);
            PG8_BAR; PG8_WAIT_L(0); PG8_MMA(0, 1, At, B1); PG8_BAR;
            PG8_LDA(At, 0, 1); PG8_STAGE(PG8_SA(0, 0), a2, voffA);
            PG8_BAR; PG8_WAIT_L(0); PG8_MMA(1, 0, At, B0); PG8_BAR; PG8_SCHED;
            PG8_STAGE(PG8_SB(0, 1), b2 + hstepB, voffB);
            PG8_WAIT_V(6); PG8_BAR; PG8_MMA(1, 1, At, B1); PG8_BAR;
            PG8_LDB(B0, 1, 0); PG8_SCHED; PG8_LDA(At, 1, 0); PG8_STAGE(PG8_SA(0, 1), a2 + hstepA, voffA);
            PG8_WAIT_L(8); PG8_BAR; PG8_WAIT_L(0); PG8_MMA(0, 0, At, B0); PG8_BAR; PG8_SCHED;
            PG8_LDB(B1, 1, 1); PG8_STAGE(PG8_SB(1, 0), b3, voffB);
            PG8_BAR; PG8_WAIT_L(0); PG8_MMA(0, 1, At, B1); PG8_BAR;
            PG8_LDA(At, 1, 1); PG8_STAGE(PG8_SA(1, 0), a3, voffA);
            PG8_BAR; PG8_WAIT_L(0); PG8_MMA(1, 0, At, B0); PG8_BAR; PG8_SCHED;
            PG8_STAGE(PG8_SB(1, 1), b3 + hstepB, voffB);
            PG8_WAIT_V(6); PG8_BAR; PG8_MMA(1, 1, At, B1); PG8_BAR;
        }
        __builtin_amdgcn_sched_barrier(0);
        E(acc, cur, sw);
        __builtin_amdgcn_sched_barrier(0);
        if (!has_next) break;
        E.init(acc, nxt, sw);
        cur = nxt; cA = nA; cB = nB; ++ui;
    }
    PG8_WAIT_V(0);
    if (wr == 0) PG8_BAR;
    PG8_BAR;
#undef PG8_SA
#undef PG8_SB
#undef PG8_STAGE
#undef PG8_LDA
#undef PG8_LDB
#undef PG8_MMA
#undef PG8_WAIT_V
#undef PG8_WAIT_L
#undef PG8_BAR
#undef PG8_SCHED
#undef PG8_ABASE
#undef PG8_BBASE
}

template <int K> __device__ __forceinline__ float row_ror(float v) { return __int_as_float(__builtin_amdgcn_update_dpp(0, __float_as_int(v), 0x120 + K, 0xF, 0xF, false)); }
typedef const f32x4 (&AccRef)[2][2][4][2];
typedef f32x4 (&AccMut)[2][2][4][2];
__device__ __forceinline__ void acc_zero(AccMut acc) {
#pragma unroll
    for (int a = 0; a < 2; ++a)
#pragma unroll
        for (int b = 0; b < 2; ++b)
#pragma unroll
            for (int m = 0; m < 4; ++m)
#pragma unroll
                for (int n = 0; n < 2; ++n) acc[a][b][m][n] = (f32x4){0.f, 0.f, 0.f, 0.f};
}
#define EPI_ZERO_INIT __device__ __forceinline__ void init(AccMut acc, const Unit&, int) const { acc_zero(acc); }
template <int ACT> struct EpiPlain {
    bf16_t* O; int ldc;
    EPI_ZERO_INIT
    __device__ __forceinline__ void operator()(AccRef acc, const Unit& u, int sw) const {
        const int tid_ = ltid(sw), lane_ = tid_ & 63, wr = sw >> 2, wc = sw & 3, fr = lane_ & 15, fq = lane_ >> 4;
        const int row0 = u.pm * BM + wr * 64 + fr, col0 = u.pn * BM + wc * 32 + 8 * fq;
#pragma unroll
        for (int ai = 0; ai < 2; ++ai)
#pragma unroll
            for (int m = 0; m < 4; ++m) { bf16_t* rowp = O + (size_t)(row0 + ai * HALF + m * 16) * ldc + col0;
#pragma unroll
                for (int bj = 0; bj < 2; ++bj) { f32x4 v0 = acc[ai][bj][m][0], v1 = acc[ai][bj][m][1];
                    if (ACT == 1) {
#pragma unroll
                        for (int j = 0; j < 4; ++j) { v0[j] = fsilu(v0[j]); v1[j] = fsilu(v1[j]); } }
                    u32x4 w; w.x = cvt_pk_bf16(v0[0], v0[1]); w.y = cvt_pk_bf16(v0[2], v0[3]); w.z = cvt_pk_bf16(v1[0], v1[1]); w.w = cvt_pk_bf16(v1[2], v1[3]);
                    *(u32x4*)(rowp + bj * HALF) = w; } }
    }
};
struct EpiUG {
    bf16_t* UG;
    EPI_ZERO_INIT
    __device__ __forceinline__ void operator()(AccRef acc, const Unit& u, int sw) const {
        const int tid_ = ltid(sw), lane_ = tid_ & 63, wr = sw >> 2, wc = sw & 3, fr = lane_ & 15, fq = lane_ >> 4;
        const int row0 = u.pm * BM + wr * 64 + fr, c0 = u.pn * 128 + wc * 32 + 8 * fq;
#pragma unroll
        for (int ai = 0; ai < 2; ++ai)
#pragma unroll
            for (int m = 0; m < 4; ++m) { bf16_t* rowp = UG + (size_t)(row0 + ai * HALF + m * 16) * E + c0;
                float y[8];
#pragma unroll
                for (int n = 0; n < 2; ++n)
#pragma unroll
                    for (int jp = 0; jp < 2; ++jp) {
                        const f32x2 uu = (f32x2){acc[ai][0][m][n][2 * jp], acc[ai][0][m][n][2 * jp + 1]}, gg = (f32x2){acc[ai][1][m][n][2 * jp], acc[ai][1][m][n][2 * jp + 1]};
                        const f32x2 za = (uu * uu * 0.044715f + 1.0f) * uu * (-1.44269504f * 1.59576912f), zg = gg * (-1.44269504f);
                        f32x2 ea, eg; ea.x = __builtin_amdgcn_exp2f(za.x); ea.y = __builtin_amdgcn_exp2f(za.y); eg.x = __builtin_amdgcn_exp2f(zg.x); eg.y = __builtin_amdgcn_exp2f(zg.y);
                        const f32x2 den = (ea + 1.0f) * (eg + 1.0f);
                        f32x2 rc; rc.x = __builtin_amdgcn_rcpf(den.x); rc.y = __builtin_amdgcn_rcpf(den.y);
                        const f32x2 yy = uu * gg * rc;
                        y[4 * n + 2 * jp] = yy.x; y[4 * n + 2 * jp + 1] = yy.y; }
                u32x4 w; w.x = cvt_pk_bf16(y[0], y[1]); w.y = cvt_pk_bf16(y[2], y[3]); w.z = cvt_pk_bf16(y[4], y[5]); w.w = cvt_pk_bf16(y[6], y[7]);
                *(u32x4*)rowp = w; }
    }
};
struct EpiVt {
    bf16_t* Vt; f32x2* VSTAT;
    EPI_ZERO_INIT
    __device__ __forceinline__ void operator()(AccRef acc, const Unit& u, int sw) const {
        const int tid_ = ltid(sw), lane_ = tid_ & 63, wr = sw >> 2, wc = sw & 3, fr = lane_ & 15, fq = lane_ >> 4;
        const int row0 = u.pm * BM + wr * 64 + fr, col0 = u.pn * BM + wc * 32 + 8 * fq;
#pragma unroll
        for (int bj = 0; bj < 2; ++bj) {
            float cs[2][4], cq[2][4];
#pragma unroll
            for (int n = 0; n < 2; ++n)
#pragma unroll
                for (int j = 0; j < 4; ++j) { cs[n][j] = 0.f; cq[n][j] = 0.f; }
#pragma unroll
            for (int ai = 0; ai < 2; ++ai)
#pragma unroll
                for (int m = 0; m < 4; ++m) { bf16_t* rowp = Vt + ((size_t)(2 * u.pn + bj) * E + (row0 + ai * HALF + m * 16)) * 128 + wc * 32 + 8 * fq;
                    f32x4 v0 = acc[ai][bj][m][0], v1 = acc[ai][bj][m][1];
#pragma unroll
                    for (int j = 0; j < 4; ++j) { v0[j] = fgelu(v0[j]); v1[j] = fgelu(v1[j]);
                        cs[0][j] += v0[j]; cq[0][j] += v0[j] * v0[j]; cs[1][j] += v1[j]; cq[1][j] += v1[j] * v1[j]; }
                    u32x4 w; w.x = cvt_pk_bf16(v0[0], v0[1]); w.y = cvt_pk_bf16(v0[2], v0[3]); w.z = cvt_pk_bf16(v1[0], v1[1]); w.w = cvt_pk_bf16(v1[2], v1[3]);
                    *(u32x4*)rowp = w; }
            f32x2* sp = VSTAT + (size_t)(u.pm * 2 + wr) * M + col0 + bj * HALF;
#pragma unroll
            for (int n = 0; n < 2; ++n)
#pragma unroll
                for (int j = 0; j < 4; ++j) { float s = cs[n][j], q = cq[n][j];
                    s += row_ror<8>(s); q += row_ror<8>(q); s += row_ror<4>(s); q += row_ror<4>(q);
                    s += row_ror<2>(s); q += row_ror<2>(q); s += row_ror<1>(s); q += row_ror<1>(q);
                    if (fr == 0) sp[4 * n + j] = (f32x2){s, q}; }
        }
    }
};
struct EpiOut {
    bf16_t* O; float* SSQ;
    EPI_ZERO_INIT
    __device__ __forceinline__ void operator()(AccRef acc, const Unit& u, int sw) const {
        const int tid_ = ltid(sw), lane_ = tid_ & 63, wr = sw >> 2, wc = sw & 3, fr = lane_ & 15, fq = lane_ >> 4;
        const int row0 = u.pm * BM + wr * 64 + fr, col0 = u.pn * BM + wc * 32 + 8 * fq;
#pragma unroll
        for (int ai = 0; ai < 2; ++ai)
#pragma unroll
            for (int m = 0; m < 4; ++m) { const int row = row0 + ai * HALF + m * 16; bf16_t* rowp = O + (size_t)row * D + col0; float s = 0.f;
#pragma unroll
                for (int bj = 0; bj < 2; ++bj) { const f32x4 v0 = acc[ai][bj][m][0], v1 = acc[ai][bj][m][1];
                    s += (v0[0] * v0[0] + v0[1] * v0[1]) + (v0[2] * v0[2] + v0[3] * v0[3]) + (v1[0] * v1[0] + v1[1] * v1[1]) + (v1[2] * v1[2] + v1[3] * v1[3]);
                    u32x4 w; w.x = cvt_pk_bf16(v0[0], v0[1]); w.y = cvt_pk_bf16(v0[2], v0[3]); w.z = cvt_pk_bf16(v1[0], v1[1]); w.w = cvt_pk_bf16(v1[2], v1[3]);
                    *(u32x4*)(rowp + bj * HALF) = w; }
                s += __shfl_xor(s, 16); s += __shfl_xor(s, 32);
                if (fq == 0) SSQ[(size_t)row * 16 + u.pn * 4 + wc] = s; }
    }
};
struct EpiConv {
    bf16_t* XC; bf16_t* XBE; const LAS float* cl;
    EPI_ZERO_INIT
    __device__ __forceinline__ void operator()(AccRef acc, const Unit& u, int sw) const {
        const int tid_ = ltid(sw), lane_ = tid_ & 63, wr = sw >> 2, wc = sw & 3, fr = lane_ & 15, fq = lane_ >> 4;
        const int row0 = u.pm * BM + wr * 64 + fr, col0 = u.pn * BM + wc * 32 + 8 * fq;
        const bool s1 = fr >= 15, s2 = fr >= 14, s3 = fr >= 13;
#pragma unroll
        for (int bj = 0; bj < 2; ++bj) { const int c = col0 + bj * HALF;
            f32x4 w0[2], w1[2], w2[2], w3[2], bb[2];
#pragma unroll
            for (int n = 0; n < 2; ++n) { const int cc = bj * HALF + wc * 32 + 8 * fq + 4 * n;
                w0[n] = *(const LAS f32x4*)(cl + 0 * 256 + cc); w1[n] = *(const LAS f32x4*)(cl + 1 * 256 + cc); w2[n] = *(const LAS f32x4*)(cl + 2 * 256 + cc);
                w3[n] = *(const LAS f32x4*)(cl + 3 * 256 + cc); bb[n] = *(const LAS f32x4*)(cl + 4 * 256 + cc); }
#pragma unroll
            for (int ai = 0; ai < 2; ++ai)
#pragma unroll
                for (int m = 0; m < 4; ++m) { const size_t off = (size_t)(row0 + ai * HALF + m * 16) * E + c;
                    float y[8], x0[8];
#pragma unroll
                    for (int n = 0; n < 2; ++n)
#pragma unroll
                        for (int j = 0; j < 4; ++j) { const float cur = acc[ai][bj][m][n][j], prev = (m > 0) ? acc[ai][bj][m > 0 ? m - 1 : 0][n][j] : 0.f;
                            const float x1 = row_ror<1>(s1 ? prev : cur), x2 = row_ror<2>(s2 ? prev : cur), x3 = row_ror<3>(s3 ? prev : cur);
                            x0[4 * n + j] = cur;
                            y[4 * n + j] = bb[n][j] + w0[n][j] * x3 + w1[n][j] * x2 + w2[n][j] * x1 + w3[n][j] * cur; }
                    if (m > 0 || fr >= 3) { u32x4 w; w.x = cvt_pk_bf16(y[0], y[1]); w.y = cvt_pk_bf16(y[2], y[3]); w.z = cvt_pk_bf16(y[4], y[5]); w.w = cvt_pk_bf16(y[6], y[7]);
                        *(u32x4*)(XC + off) = w; }
                    if ((m == 0 && fr < 3) || (m == 3 && fr >= 13)) { u32x4 w; w.x = cvt_pk_bf16(x0[0], x0[1]); w.y = cvt_pk_bf16(x0[2], x0[3]); w.z = cvt_pk_bf16(x0[4], x0[5]); w.w = cvt_pk_bf16(x0[6], x0[7]);
                        *(u32x4*)(XBE + off) = w; } }
        }
    }
};
struct EpiGate {
    const bf16_t* XC; bf16_t* LA; bf16_t* BT; const LAS float* gab; const LAS float* gxb; const LAS float* nsp;
    __device__ __forceinline__ void init(AccMut acc, const Unit& u, int sw) const {
        const int tid_ = ltid(sw), lane_ = tid_ & 63, wc = sw & 3, fq = lane_ >> 4;
        const int c0 = u.pn * 128 + wc * 32 + 8 * fq;
#pragma unroll
        for (int n = 0; n < 2; ++n) { const f32x4 ga = *(const LAS f32x4*)(gab + c0 + 4 * n), gx = *(const LAS f32x4*)(gxb + c0 + 4 * n);
#pragma unroll
            for (int ai = 0; ai < 2; ++ai)
#pragma unroll
                for (int m = 0; m < 4; ++m) { acc[ai][0][m][n] = ga; acc[ai][1][m][n] = gx; } }
    }
    __device__ __forceinline__ void operator()(AccMut acc, const Unit& u, int sw) const {
        const int tid_ = ltid(sw), lane_ = tid_ & 63, wr = sw >> 2, wc = sw & 3, fr = lane_ & 15, fq = lane_ >> 4;
        const int row0 = u.pm * BM + wr * 64 + fr, c0 = u.pn * 128 + wc * 32 + 8 * fq;
        u32x4 xnext = *(const u32x4*)(XC + (size_t)row0 * E + c0);
        { f32x4 ns[2];
#pragma unroll
          for (int n = 0; n < 2; ++n) ns[n] = *(const LAS f32x4*)(nsp + c0 + 4 * n);
#pragma unroll
          for (int ai = 0; ai < 2; ++ai)
#pragma unroll
            for (int m = 0; m < 4; ++m) {
#pragma unroll
                for (int n = 0; n < 2; ++n)
#pragma unroll
                    for (int jp = 0; jp < 2; ++jp) {
                        const f32x2 z = (f32x2){acc[ai][0][m][n][2 * jp], acc[ai][0][m][n][2 * jp + 1]} * (-1.44269504f);
                        f32x2 e; e.x = __builtin_amdgcn_exp2f(z.x); e.y = __builtin_amdgcn_exp2f(z.y); e = e + 1.0f;
                        f32x2 r; r.x = __builtin_amdgcn_rcpf(e.x); r.y = __builtin_amdgcn_rcpf(e.y);
                        r = r * (f32x2){ns[n][2 * jp], ns[n][2 * jp + 1]};
                        acc[ai][0][m][n][2 * jp] = r.x; acc[ai][0][m][n][2 * jp + 1] = r.y; }
                const f32x4 l0 = acc[ai][0][m][0], l1 = acc[ai][0][m][1];
                u32x4 w; w.x = cvt_pk_bf16(l0[0], l0[1]); w.y = cvt_pk_bf16(l0[2], l0[3]); w.z = cvt_pk_bf16(l1[0], l1[1]); w.w = cvt_pk_bf16(l1[2], l1[3]);
                *(u32x4*)(LA + (size_t)(row0 + ai * HALF + m * 16) * E + c0) = w; } }
#pragma unroll
        for (int ai = 0; ai < 2; ++ai)
#pragma unroll
            for (int m = 0; m < 4; ++m) { const size_t off = (size_t)(row0 + ai * HALF + m * 16) * E + c0;
                const u32x4 xw = xnext;
                if (ai * 4 + m < 7) { const int ai2 = (ai * 4 + m + 1) >> 2, m2 = (ai * 4 + m + 1) & 3; xnext = *(const u32x4*)(XC + (size_t)(row0 + ai2 * HALF + m2 * 16) * E + c0); }
                float bt[8];
#pragma unroll
                for (int n = 0; n < 2; ++n)
#pragma unroll
                    for (int jp = 0; jp < 2; ++jp) {
                        const f32x2 z = (f32x2){acc[ai][1][m][n][2 * jp], acc[ai][1][m][n][2 * jp + 1]} * (-1.44269504f);
                        f32x2 e; e.x = __builtin_amdgcn_exp2f(z.x); e.y = __builtin_amdgcn_exp2f(z.y); e = e + 1.0f;
                        f32x2 ig; ig.x = __builtin_amdgcn_rcpf(e.x); ig.y = __builtin_amdgcn_rcpf(e.y);
                        const f32x2 x2 = (f32x2){acc[ai][0][m][n][2 * jp], acc[ai][0][m][n][2 * jp + 1]} * 2.0f;
                        f32x2 ser = x2 * (1.0f / 120.0f) + (1.0f / 24.0f); ser = ser * x2 + (1.0f / 6.0f); ser = ser * x2 + 0.5f; ser = ser * x2 + 1.0f; ser = ser * (-x2);
                        f32x2 em = ser;
                        if (__builtin_expect(__builtin_amdgcn_ballot_w64(x2.x <= -0.25f || x2.y <= -0.25f) != 0ull, 0)) {
                            em.x = (x2.x > -0.25f) ? ser.x : (1.0f - fexp(x2.x)); em.y = (x2.y > -0.25f) ? ser.y : (1.0f - fexp(x2.y)); }
                        const unsigned wv = xw[2 * n + jp];
                        f32x2 sq; sq.x = __builtin_amdgcn_sqrtf(em.x); sq.y = __builtin_amdgcn_sqrtf(em.y);
                        const f32x2 b2 = sq * ig * (f32x2){bf_lo(wv), bf_hi(wv)};
                        bt[4 * n + 2 * jp] = b2.x; bt[4 * n + 2 * jp + 1] = b2.y; }
                u32x4 w; w.x = cvt_pk_bf16(bt[0], bt[1]); w.y = cvt_pk_bf16(bt[2], bt[3]); w.z = cvt_pk_bf16(bt[4], bt[5]); w.w = cvt_pk_bf16(bt[6], bt[7]);
                *(u32x4*)(BT + off) = w; }
    }
};
}

struct Args { const float* in[20]; float* out; unsigned char* ws; };
extern __shared__ __attribute__((aligned(16))) unsigned char lds_raw[];
__device__ __forceinline__ const float* argp(int i) {
    const __attribute__((address_space(4))) unsigned long long* kp = (const __attribute__((address_space(4))) unsigned long long*)__builtin_amdgcn_kernarg_segment_ptr();
    asm volatile("" : "+s"(kp));
    return (const float*)(const __attribute__((address_space(1))) float*)kp[i];
}
#define ARG_OUT ((float*)argp(20))
#define ARG_WS ((unsigned char*)argp(21))
enum { I_X = 0, I_C, I_MODW, I_MODB, I_PRE, I_POST, I_AWIN, I_AVN, I_AWS, I_ABS, I_AWOUT, I_BWIN, I_BCW, I_BCB, I_BGAW, I_BGAB, I_BGXW, I_BGXB, I_BLAM, I_BWOUT };

__device__ __forceinline__ void tr_item(const float* W, int ldw, int k0, int n0, bf16_t* WT, int ldt, int drow0, LAS float* scr, int lane) {
#pragma unroll 8
    for (int i = 0; i < 32; ++i) { const int kk = 2 * i + (lane >> 5); scr[kk * 33 + (lane & 31)] = ntload(W + (size_t)(k0 + kk) * ldw + n0 + (lane & 31)); }
    LDS_WAIT();
    const int c = lane & 7;
#pragma unroll
    for (int j = 0; j < 4; ++j) { const int n = (lane >> 3) + 8 * j; const LAS float* s = scr + (8 * c) * 33 + n;
        u32x4 o; o.x = cvt_pk_bf16(s[0 * 33], s[1 * 33]); o.y = cvt_pk_bf16(s[2 * 33], s[3 * 33]); o.z = cvt_pk_bf16(s[4 * 33], s[5 * 33]); o.w = cvt_pk_bf16(s[6 * 33], s[7 * 33]);
        *(u32x4*)(WT + (size_t)(drow0 + n) * ldt + k0 + 8 * c) = o; }
    LDS_WAIT();
}
__device__ __forceinline__ void convert_layer(int l, LAS unsigned char* lds, int sw) {
    const int tid = ltid(sw), lane = tid & 63, wave = __builtin_amdgcn_readfirstlane(tid >> 6);
    LAS float* scr = (LAS float*)(lds + wave * 16384);
    const int gw = lbid() * 8 + wave, NGW = lgrid() * 8, j = l >> 1;
    bf16_t* Wr = (bf16_t*)(ARG_WS + ((l & 1) ? WS_W2 : WS_W));
    if (!(l & 1)) {
        bf16_t* Wug = Wr; bf16_t* Wv = Wr + 4 * MiB; bf16_t* Wout = Wr + 6 * MiB;
        for (int it = gw; it < 4096; it += NGW) {
            if (it < 3072) { const int kb = it / 192, nb = it % 192, n0 = 32 * nb; bf16_t* dst; int drow0;
                if (n0 < 2048) { dst = Wug; drow0 = 256 * (n0 >> 7) + (n0 & 127); }
                else if (n0 < 4096) { dst = Wv; drow0 = n0 - 2048; }
                else { const int c = n0 - 4096; dst = Wug; drow0 = 256 * (c >> 7) + 128 + (c & 127); }
                tr_item(argp(I_AWIN) + (size_t)j * 1024 * 6144, 6144, 64 * kb, n0, dst, 1024, drow0, scr, lane); }
            else { const int r = it - 3072, kb = r >> 5, nb = r & 31;
                tr_item(argp(I_AWOUT) + (size_t)j * 2048 * 1024, 1024, 64 * kb, 32 * nb, Wout, 2048, 32 * nb, scr, lane); }
        }
    } else {
        bf16_t* Wx = Wr; bf16_t* Wg = Wr + 2 * MiB; bf16_t* Wgate = Wr + 4 * MiB; bf16_t* Wout = Wr + 6 * MiB;
        for (int it = gw; it < 3584; it += NGW) {
            if (it < 2048) { const int kb = it >> 7, nb = it & 127, n0 = 32 * nb;
                tr_item(argp(I_BWIN) + (size_t)j * 1024 * 4096, 4096, 64 * kb, n0, n0 < 2048 ? Wx : Wg, 1024, n0 & 2047, scr, lane); }
            else if (it < 3072) { const int r = it - 2048, kb = r >> 5, nb = r & 31;
                tr_item(argp(I_BWOUT) + (size_t)j * 2048 * 1024, 1024, 64 * kb, 32 * nb, Wout, 2048, 32 * nb, scr, lane); }
            else { const int r = it - 3072, which = r >> 8, r2 = r & 255, h = r2 >> 5, r3 = r2 & 31, kb = r3 >> 3, nb = r3 & 7, n0 = 32 * nb;
                const float* W = argp(which ? I_BGXW : I_BGAW) + (size_t)(j * 8 + h) * 256 * 256;
                tr_item(W, 256, 64 * kb, n0, Wgate, 256, (2 * h + (n0 >> 7)) * 256 + which * 128 + (n0 & 127), scr, lane); }
        }
    }
}
__device__ __forceinline__ void mod_phase(LAS unsigned char* lds, int sw) {
    const int tid = ltid(sw), wave = tid >> 6, lane = tid & 63;
    unsigned char* ws = ARG_WS; float* mod = (float*)(ws + WS_MOD); float* nsp = (float*)(ws + WS_NSP);
    const float* lam = argp(I_BLAM); const float* cin = argp(I_C); const float* modw = argp(I_MODW); const float* modb = argp(I_MODB);
    const int bid = lbid(), nblk = lgrid();
    if (bid == nblk - 1) for (int i = tid; i < 4096; i += 512) nsp[i] = -8.0f * log1pf(expf(-lam[i]));
    LAS float* sc = (LAS float*)lds; LAS float* red = (LAS float*)(lds + 32768);
    for (int item = bid; item < 192; item += nblk) {
        __syncthreads();
        for (int i = tid; i < 8192; i += 512) { const float v = cin[i]; sc[i] = v / (1.0f + expf(-v)); }
        __syncthreads();
        const int l = item / 48, n0 = (item % 48) * 64;
        const float* W = modw + ((size_t)l * 1024 + wave * 128) * 3072 + n0 + lane;
        float acc[8];
#pragma unroll
        for (int b = 0; b < 8; ++b) acc[b] = 0.f;
        for (int k = 0; k < 128; k += 4) {
            const float w0 = ntload(W + (size_t)(k + 0) * 3072), w1 = ntload(W + (size_t)(k + 1) * 3072), w2 = ntload(W + (size_t)(k + 2) * 3072), w3 = ntload(W + (size_t)(k + 3) * 3072);
#pragma unroll
            for (int b = 0; b < 8; ++b) { const f32x4 s = *(const LAS f32x4*)(sc + b * 1024 + wave * 128 + k); acc[b] += (s[0] * w0 + s[1] * w1) + (s[2] * w2 + s[3] * w3); }
        }
#pragma unroll
        for (int b = 0; b < 8; ++b) red[(wave * 8 + b) * 64 + lane] = acc[b];
        __syncthreads();
        { const int b = wave; float s = 0.f;
#pragma unroll
          for (int w = 0; w < 8; ++w) s += red[(w * 8 + b) * 64 + lane];
          const int n = n0 + lane; mod[(size_t)(l * 8 + b) * 3072 + n] = s + modb[l * 3072 + n]; }
    }
    __syncthreads();
}

__device__ __forceinline__ void final_phase(int l, const bf16_t* OUT, int sw, View vw) {
    vw = lview(vw);
    const int tid = ltid(sw), lane = tid & 63, wave = __builtin_amdgcn_readfirstlane(tid >> 6);
    const int gw = vw.vb * 8 + wave, NGW = vw.vG * 8;
    unsigned char* ws = ARG_WS; float* xout = ARG_OUT;
    const float* xin = (l <= 0) ? argp(I_X) : (const float*)xout;
    const float* mod = (const float*)(ws + WS_MOD); const float* SSQ = (const float*)(ws + WS_SSQ);
    bf16_t* H = (bf16_t*)(ws + WS_H);
    const float* postn = argp(I_POST) + (l < 0 ? 0 : l) * D; const float* pren = argp(I_PRE) + (l + 1 < DEPTH ? l + 1 : 0) * D;
    constexpr int RB = 8;
    for (int r0 = vw.row0 + gw; r0 < vw.row0 + vw.MR; r0 += RB * NGW) {
        f32x4 v[RB][4]; u32x2 o[RB][4]; float ss[RB];
#pragma unroll
        for (int k = 0; k < RB; ++k) { const int r = r0 + k * NGW;
#pragma unroll
            for (int j = 0; j < 4; ++j) v[k][j] = ntload((const f32x4*)(xin + (size_t)r * D + 4 * lane + 256 * j));
            if (l >= 0) {
#pragma unroll
                for (int j = 0; j < 4; ++j) o[k][j] = ntload((const u32x2*)(OUT + (size_t)r * D + 4 * lane + 256 * j));
                ss[k] = (lane < 16) ? SSQ[(size_t)r * 16 + lane] : 0.f; } }
        if (l >= 0) {
            float rs[RB];
#pragma unroll
            for (int k = 0; k < RB; ++k) rs[k] = 1.0f / sqrtf(wave_sum(ss[k]) * (1.0f / D) + EPS);
#pragma unroll
            for (int j = 0; j < 4; ++j) { const int col = 4 * lane + 256 * j;
                const f32x4 p = *(const f32x4*)(postn + col); f32x4 g = (f32x4){0.f, 0.f, 0.f, 0.f}; int bprev = -1;
#pragma unroll
                for (int k = 0; k < RB; ++k) { const int r = r0 + k * NGW, b = r >> 12;
                    if (b != bprev) { g = *(const f32x4*)(mod + (size_t)(l * 8 + b) * 3072 + 2048 + col); bprev = b; }
                    const float rstd = rs[k];
                    v[k][j][0] += g[0] * (bf_lo(o[k][j].x) * rstd * p[0]); v[k][j][1] += g[1] * (bf_hi(o[k][j].x) * rstd * p[1]);
                    v[k][j][2] += g[2] * (bf_lo(o[k][j].y) * rstd * p[2]); v[k][j][3] += g[3] * (bf_hi(o[k][j].y) * rstd * p[3]);
                    __builtin_nontemporal_store(v[k][j], (f32x4*)(xout + (size_t)r * D + col)); } }
        }
        if (l + 1 < DEPTH) {
            float rs[RB];
#pragma unroll
            for (int k = 0; k < RB; ++k) { float s = 0.f;
#pragma unroll
                for (int j = 0; j < 4; ++j) s += (v[k][j][0] * v[k][j][0] + v[k][j][1] * v[k][j][1]) + (v[k][j][2] * v[k][j][2] + v[k][j][3] * v[k][j][3]);
                rs[k] = 1.0f / sqrtf(wave_sum(s) * (1.0f / D) + EPS); }
#pragma unroll
            for (int j = 0; j < 4; ++j) { const int col = 4 * lane + 256 * j;
                const f32x4 p = *(const f32x4*)(pren + col); f32x4 sh = (f32x4){0.f, 0.f, 0.f, 0.f}, sc = sh; int bprev = -1;
#pragma unroll
                for (int k = 0; k < RB; ++k) { const int r = r0 + k * NGW, b = r >> 12;
                    if (b != bprev) { const float* md = mod + (size_t)((l + 1) * 8 + b) * 3072; sh = *(const f32x4*)(md + col); sc = *(const f32x4*)(md + 1024 + col); bprev = b; }
                    float h[4];
#pragma unroll
                    for (int e = 0; e < 4; ++e) h[e] = v[k][j][e] * rs[k] * p[e] * (1.0f + sc[e]) + sh[e];
                    u32x2 w; w.x = cvt_pk_bf16(h[0], h[1]); w.y = cvt_pk_bf16(h[2], h[3]);
                    *(u32x2*)(H + (size_t)r * D + col) = w; } }
        }
    }
}

__device__ __forceinline__ void build_wp(const float* wsrc_g, LAS unsigned char* WPb, LAS float* M2b, const LAS float* MU, const LAS float* RS, int tid) {
    const int t = tid >> 2, part = tid & 3, s0 = 32 * part;
    const float* wsrc = wsrc_g + t * 128 + s0;
    float m2 = 0.f;
#pragma unroll
    for (int q = 0; q < 4; ++q) { const f32x4 w0 = *(const f32x4*)(wsrc + 8 * q), w1 = *(const f32x4*)(wsrc + 8 * q + 4);
        const float wv[8] = {w0[0], w0[1], w0[2], w0[3], w1[0], w1[1], w1[2], w1[3]};
        unsigned pk[4];
#pragma unroll
        for (int e = 0; e < 8; e += 2) { const int s = s0 + 8 * q + e;
            const float x0 = (s <= t) ? wv[e] * RS[s] : 0.f, x1 = (s + 1 <= t) ? wv[e + 1] * RS[s + 1] : 0.f;
            const unsigned p = cvt_pk_bf16(x0, x1); pk[e >> 1] = p;
            m2 += bf_lo(p) * MU[s] + bf_hi(p) * MU[s + 1]; }
        *(LAS u32x4*)(WPb + t * 272 + (s0 + 8 * q) * 2) = (u32x4){pk[0], pk[1], pk[2], pk[3]}; }
    m2 += __shfl_xor(m2, 1); m2 += __shfl_xor(m2, 2);
    if (part == 0) M2b[t] = m2;
}
__device__ __forceinline__ void spatial_phase(int j, const bf16_t* UG, bf16_t* Y, const bf16_t* Vt, LAS unsigned char* lds, int sw, View vw) {
    vw = lview(vw);
    const int tid = ltid(sw), bid = vw.vb, nblk = vw.vG;
    const int wave = __builtin_amdgcn_readfirstlane(tid >> 6), lane = tid & 63, fr = lane & 15, fq = lane >> 4;
    const f32x2* VSTAT = (const f32x2*)(ARG_WS + WS_VSTAT);
    const float* aws = argp(I_AWS) + (size_t)j * 8 * 128 * 128; const float* abs_ = argp(I_ABS) + (size_t)j * 8 * 128;
    constexpr int WPITCH = 272, WPB = 128 * WPITCH;
    LAS float* MU = (LAS float*)(lds + 2 * WPB); LAS float* RS = MU + 128; LAS float* M2 = MU + 256;
    const float* gamma = argp(I_AVN) + j * E;
    const int vrow = 8 * (fr >> 2) + (fr & 3);
    for (int chunk = (vw.row0 >> 7) + bid; chunk < ((vw.row0 + vw.MR) >> 7); chunk += nblk) {
        const int tok0 = chunk * 128;
        __syncthreads();
        if (tid < 128) { float s = 0.f, q = 0.f;
#pragma unroll
            for (int p = 0; p < 16; ++p) { const f32x2 v = VSTAT[(size_t)p * M + tok0 + tid]; s += v[0]; q += v[1]; }
            const float mu = s * (1.0f / E), var = q * (1.0f / E) - mu * mu;
            MU[tid] = mu; RS[tid] = 1.0f / sqrtf(var + EPS); }
        __syncthreads();
        build_wp(aws, lds, M2, MU, RS, tid);
        bf16x8 vf[2][4]; u32x4 ug[8];
        const unsigned vlo = (unsigned)(vrow * 128 + 8 * fq), ulo = (unsigned)(fr * E + 8 * fq);
        { const bf16_t* vp = Vt + ((size_t)chunk * E + 32 * wave) * 128;
#pragma unroll
          for (int f = 0; f < 2; ++f)
#pragma unroll
            for (int ks = 0; ks < 4; ++ks) vf[f][ks] = ntload((const bf16x8*)(vp + (4 * f) * 128 + 32 * ks + vlo)); }
        __syncthreads();
        for (int g = 0; g < 8; ++g) {
            const int buf = g & 1, ch0 = 256 * g + 32 * wave;
            const bf16_t* up = UG + (size_t)tok0 * E + ch0; bf16_t* yp = Y + (size_t)tok0 * E + ch0;
#pragma unroll
            for (int i = 0; i < 8; ++i) ug[i] = ntload((const u32x4*)(up + (size_t)(16 * i) * E + ulo));
            if (g < 7) {
                build_wp(aws + (size_t)(g + 1) * 128 * 128, lds + (buf ^ 1) * WPB, M2 + (buf ^ 1) * 128, MU, RS, tid);
            }
            const LAS unsigned char* WP = lds + buf * WPB; const LAS float* M2c = M2 + buf * 128;
            f32x4 acc[2][8];
#pragma unroll
            for (int f = 0; f < 2; ++f)
#pragma unroll
                for (int i = 0; i < 8; ++i) acc[f][i] = (f32x4){0.f, 0.f, 0.f, 0.f};
#pragma unroll
            for (int i = 0; i < 8; ++i)
#pragma unroll
                for (int ks = 0; ks <= (i >> 1); ++ks) {
                    const bf16x8 wf = *(const LAS bf16x8*)(WP + (16 * i + fr) * WPITCH + (32 * ks + 8 * fq) * 2);
#pragma unroll
                    for (int f = 0; f < 2; ++f) acc[f][i] = __builtin_amdgcn_mfma_f32_16x16x32_bf16(vf[f][ks], wf, acc[f][i], 0, 0, 0);
                }
            if (g < 7) {
                const bf16_t* vp = Vt + ((size_t)chunk * E + ch0 + 256) * 128;
#pragma unroll
                for (int f = 0; f < 2; ++f)
#pragma unroll
                    for (int ks = 0; ks < 4; ++ks) vf[f][ks] = ntload((const bf16x8*)(vp + (4 * f) * 128 + 32 * ks + vlo));
            }
            const float* bsp = abs_ + g * 128;
            const f32x4 gm0 = *(const f32x4*)(gamma + ch0 + 8 * fq), gm1 = *(const f32x4*)(gamma + ch0 + 8 * fq + 4);
#pragma unroll
            for (int i = 0; i < 8; ++i) { const int t = 16 * i + fr; const float m2 = M2c[t], bs = bsp[t];
                const u32x4 u4 = ug[i];
                const float y0 = bf_lo(u4.x) * (gm0[0] * (acc[0][i][0] - m2) + bs), y1 = bf_hi(u4.x) * (gm0[1] * (acc[0][i][1] - m2) + bs);
                const float y2 = bf_lo(u4.y) * (gm0[2] * (acc[0][i][2] - m2) + bs), y3 = bf_hi(u4.y) * (gm0[3] * (acc[0][i][3] - m2) + bs);
                const float y4 = bf_lo(u4.z) * (gm1[0] * (acc[1][i][0] - m2) + bs), y5 = bf_hi(u4.z) * (gm1[1] * (acc[1][i][1] - m2) + bs);
                const float y6 = bf_lo(u4.w) * (gm1[2] * (acc[1][i][2] - m2) + bs), y7 = bf_hi(u4.w) * (gm1[3] * (acc[1][i][3] - m2) + bs);
                u32x4 w; w.x = cvt_pk_bf16(y0, y1); w.y = cvt_pk_bf16(y2, y3); w.z = cvt_pk_bf16(y4, y5); w.w = cvt_pk_bf16(y6, y7);
                *(u32x4*)(yp + (size_t)(16 * i) * E + ulo) = w; }
            __syncthreads();
        }
    }
    __syncthreads();
}

__device__ __forceinline__ void conv_edge_phase(int j, const bf16_t* XBE, bf16_t* XC, int sw, View vw) {
    vw = lview(vw);
    const int tid = ltid(sw), gtid = vw.vb * 512 + tid, NT = vw.vG * 512;
    const float* cw = argp(I_BCW) + (size_t)j * 4 * E; const float* cb = argp(I_BCB) + (size_t)j * E;
    for (int idx = gtid; idx < (vw.MR / 64) * 256; idx += NT) {
        const int slab = (vw.row0 >> 6) + (idx >> 8), o = idx & 255, c0 = 8 * o, r0 = slab * 64;
        float w[4][8], bias[8];
#pragma unroll
        for (int k = 0; k < 4; ++k) { const f32x4 t0 = *(const f32x4*)(cw + k * E + c0), t1 = *(const f32x4*)(cw + k * E + c0 + 4);
#pragma unroll
            for (int e = 0; e < 4; ++e) { w[k][e] = t0[e]; w[k][4 + e] = t1[e]; } }
        { const f32x4 t0 = *(const f32x4*)(cb + c0), t1 = *(const f32x4*)(cb + c0 + 4);
#pragma unroll
          for (int e = 0; e < 4; ++e) { bias[e] = t0[e]; bias[4 + e] = t1[e]; } }
        const bool head = ((r0 & (SEQ - 1)) == 0);
        u32x4 p[6];
        const bf16_t* xb = XBE + (size_t)r0 * E + c0;
#pragma unroll
        for (int i = 0; i < 3; ++i) p[i] = head ? (u32x4){0u, 0u, 0u, 0u} : *(const u32x4*)(xb + (ptrdiff_t)(i - 3) * E);
#pragma unroll
        for (int i = 0; i < 3; ++i) p[3 + i] = *(const u32x4*)(xb + (size_t)i * E);
        bf16_t* xc = XC + (size_t)r0 * E + c0;
#pragma unroll
        for (int tt = 0; tt < 3; ++tt) {
            float y[8];
#pragma unroll
            for (int e = 0; e < 4; ++e) {
                y[2 * e]     = bias[2 * e]     + w[0][2 * e]     * bf_lo(p[tt][e]) + w[1][2 * e]     * bf_lo(p[tt + 1][e]) + w[2][2 * e]     * bf_lo(p[tt + 2][e]) + w[3][2 * e]     * bf_lo(p[tt + 3][e]);
                y[2 * e + 1] = bias[2 * e + 1] + w[0][2 * e + 1] * bf_hi(p[tt][e]) + w[1][2 * e + 1] * bf_hi(p[tt + 1][e]) + w[2][2 * e + 1] * bf_hi(p[tt + 2][e]) + w[3][2 * e + 1] * bf_hi(p[tt + 3][e]); }
            u32x4 o4; o4.x = cvt_pk_bf16(y[0], y[1]); o4.y = cvt_pk_bf16(y[2], y[3]); o4.z = cvt_pk_bf16(y[4], y[5]); o4.w = cvt_pk_bf16(y[6], y[7]);
            *(u32x4*)(xc + (size_t)tt * E) = o4;
        }
    }
}

__device__ __forceinline__ void scan1_phase(const bf16_t* LA, const bf16_t* BT, int sw, View vw) {
    vw = lview(vw);
    const int tid = ltid(sw), gtid = vw.vb * 512 + tid, NT = vw.vG * 512;
    unsigned char* ws = ARG_WS; float* CP = (float*)(ws + WS_CP); float* CH = (float*)(ws + WS_CH);
    for (int idx = gtid; idx < (vw.MR >> 6) * 512; idx += NT) {
        const int quad = idx & 511, bq = (vw.row0 >> 6) + (idx >> 9);
        const size_t base = (size_t)bq * 64 * E + 4 * quad;
        float S[4] = {0.f, 0.f, 0.f, 0.f}, Hc[4] = {0.f, 0.f, 0.f, 0.f};
#pragma unroll 1
        for (int tb = 0; tb < 64; tb += 16) {
            u32x2 lw[16], bw[16];
#pragma unroll
            for (int i = 0; i < 16; ++i) { lw[i] = *(const u32x2*)(LA + base + (size_t)(tb + i) * E); bw[i] = *(const u32x2*)(BT + base + (size_t)(tb + i) * E); }
#pragma unroll
            for (int i = 0; i < 16; ++i) {
                const float l0 = bf_lo(lw[i].x), l1 = bf_hi(lw[i].x), l2 = bf_lo(lw[i].y), l3 = bf_hi(lw[i].y);
                S[0] += l0; S[1] += l1; S[2] += l2; S[3] += l3;
                Hc[0] = fexp(l0) * Hc[0] + bf_lo(bw[i].x); Hc[1] = fexp(l1) * Hc[1] + bf_hi(bw[i].x); Hc[2] = fexp(l2) * Hc[2] + bf_lo(bw[i].y); Hc[3] = fexp(l3) * Hc[3] + bf_hi(bw[i].y); }
        }
        *(f32x4*)(CP + (size_t)bq * E + 4 * quad) = (f32x4){S[0], S[1], S[2], S[3]};
        *(f32x4*)(CH + (size_t)bq * E + 4 * quad) = (f32x4){Hc[0], Hc[1], Hc[2], Hc[3]};
    }
}
__device__ __forceinline__ void scan2_phase(const bf16_t* LA, const bf16_t* BT, bf16_t* GS, int sw, View vw) {
    vw = lview(vw);
    const int tid = ltid(sw), gtid = vw.vb * 512 + tid, NT = vw.vG * 512;
    unsigned char* ws = ARG_WS; const float* CP = (const float*)(ws + WS_CP); const float* CH = (const float*)(ws + WS_CH);
    for (int idx = gtid; idx < (vw.MR >> 6) * 512; idx += NT) {
        const int quad = idx & 511, bq = (vw.row0 >> 6) + (idx >> 9), q = bq & 63, b = bq >> 6;
        const size_t base = (size_t)bq * 64 * E + 4 * quad;
        u32x2 lw[8], bw[8], gw[8];
#pragma unroll
        for (int i = 0; i < 8; ++i) { lw[i] = ntload((const u32x2*)(LA + base + (size_t)i * E)); bw[i] = ntload((const u32x2*)(BT + base + (size_t)i * E)); gw[i] = ntload((const u32x2*)(GS + base + (size_t)i * E)); }
        float h[4] = {0.f, 0.f, 0.f, 0.f};
        const float* cp = CP + (size_t)(b * 64) * E + 4 * quad; const float* chp = CH + (size_t)(b * 64) * E + 4 * quad;
        int qq = 0;
        for (; qq + 8 <= q; qq += 8) {
            f32x4 P[8], Hq[8];
#pragma unroll
            for (int i = 0; i < 8; ++i) { P[i] = *(const f32x4*)(cp + (size_t)(qq + i) * E); Hq[i] = *(const f32x4*)(chp + (size_t)(qq + i) * E); }
#pragma unroll
            for (int i = 0; i < 8; ++i)
#pragma unroll
                for (int e = 0; e < 4; ++e) h[e] = fexp(P[i][e]) * h[e] + Hq[i][e];
        }
        for (; qq < q; ++qq) { const f32x4 P = *(const f32x4*)(cp + (size_t)qq * E), Hq = *(const f32x4*)(chp + (size_t)qq * E);
#pragma unroll
            for (int e = 0; e < 4; ++e) h[e] = fexp(P[e]) * h[e] + Hq[e]; }
#pragma unroll 1
        for (int tb = 0; tb < 64; tb += 8) {
            u32x2 lwn[8], bwn[8], gwn[8];
            if (tb + 8 < 64) {
#pragma unroll
                for (int i = 0; i < 8; ++i) { lwn[i] = ntload((const u32x2*)(LA + base + (size_t)(tb + 8 + i) * E)); bwn[i] = ntload((const u32x2*)(BT + base + (size_t)(tb + 8 + i) * E)); gwn[i] = ntload((const u32x2*)(GS + base + (size_t)(tb + 8 + i) * E)); }
            }
            u32x2 w[8];
#pragma unroll
            for (int i = 0; i < 8; ++i) {
                h[0] = fexp(bf_lo(lw[i].x)) * h[0] + bf_lo(bw[i].x); h[1] = fexp(bf_hi(lw[i].x)) * h[1] + bf_hi(bw[i].x);
                h[2] = fexp(bf_lo(lw[i].y)) * h[2] + bf_lo(bw[i].y); h[3] = fexp(bf_hi(lw[i].y)) * h[3] + bf_hi(bw[i].y);
                w[i].x = cvt_pk_bf16(h[0] * fsilu(bf_lo(gw[i].x)), h[1] * fsilu(bf_hi(gw[i].x))); w[i].y = cvt_pk_bf16(h[2] * fsilu(bf_lo(gw[i].y)), h[3] * fsilu(bf_hi(gw[i].y))); }
#pragma unroll
            for (int i = 0; i < 8; ++i) *(u32x2*)(GS + base + (size_t)(tb + i) * E) = w[i];
            if (tb + 8 < 64) {
#pragma unroll
                for (int i = 0; i < 8; ++i) { lw[i] = lwn[i]; bw[i] = bwn[i]; gw[i] = gwn[i]; }
            }
        }
    }
}

__device__ __forceinline__ volatile LAS unsigned* lctl() { unsigned off = (unsigned)LDS_CTL_OFF; asm volatile("" : "+s"(off)); return (volatile LAS unsigned*)((LAS unsigned char*)lds_raw + off); }
__global__ void __launch_bounds__(512, 2) mega_fwd(Args a) {
    LAS unsigned char* lds = (LAS unsigned char*)lds_raw;
    volatile LAS unsigned* ctlw0 = (volatile LAS unsigned*)(lds + LDS_CTL_OFF);
#define ctlw lctl()
    const int sw = __builtin_amdgcn_readfirstlane((int)threadIdx.x >> 6);
    { const int tid = threadIdx.x;
      if (tid < 64) ctlw0[tid] = 0u;
      __syncthreads();
      const XcdBarrier b0 = xcd_barrier_post((unsigned*)(ARG_WS + WS_CTL), ctlw0 + 8);
      if (tid == 0) ctlw0[10] = b0.x;
      __syncthreads(); }
#define BAR_(loc) do { XcdBarrier bb_; bb_.bar = (unsigned*)(ARG_WS + WS_CTL); bb_.st = ctlw + 8; bb_.x = ctlw[10]; xcd_barrier(bb_, (loc)); } while (0)
#define GRID_BAR() BAR_(0)
#define SEAM_BAR() BAR_((int)ctlw[12])
#define WSB(off) ((bf16_t*)(ARG_WS + (off)))
#define WSW(eoff) ((bf16_t*)(ARG_WS + ((l & 1) ? WS_W2 : WS_W)) + (eoff))
#define VIEW() (ctlw[12] ? View{(int)__builtin_amdgcn_readfirstlane((int)ctlw[11]), 32, (int)__builtin_amdgcn_readfirstlane((int)ctlw[10]) * (M / 8), M / 8} : View{lbid(), lgrid(), 0, M})

    mod_phase(lds, sw);
    convert_layer(0, lds, sw);
    if (__hip_atomic_load((unsigned*)(ARG_WS + WS_CTL) + 64, __ATOMIC_RELAXED, __HIP_MEMORY_SCOPE_AGENT) == 0xffffffffu) cg::this_grid().sync();
    GRID_BAR();
    if (threadIdx.x == 0) { unsigned* bar_ = (unsigned*)(ARG_WS + WS_CTL); unsigned ok = (lgrid() == 256) ? 1u : 0u;
        for (unsigned j_ = 0; j_ < 16; ++j_) ok &= (xb_ld(&bar_[XB_XCNT(j_)]) == (j_ < 8u ? 32u : 0u)) ? 1u : 0u;
        ok &= (ctlw[10] < 8u && ctlw[11] < 32u) ? 1u : 0u;
        ctlw[12] = ok; }
    __syncthreads();
    final_phase(-1, nullptr, sw, VIEW());
    SEAM_BAR();

    for (int l = 0; l < DEPTH; ++l) {
        const int j = l >> 1;
        if (!(l & 1)) {
            { const View vw = VIEW(); const size_t ro = (size_t)vw.row0;
              { pg8::Gemm g{WSB(WS_H) + ro * D, WSW(0), D, D, D, 0}; pg8::StaticOrder S; S.init(vw.MR / 256, 4096 / 256, vw.vG, vw.vb);
                pg8::EpiUG Ep{WSB(WS_R1) + ro * E}; pg8::gemm_phase(lds, g, S, Ep, sw); }
              { pg8::Gemm g{WSW(4 * MiB), WSB(WS_H) + ro * D, D, D, D, 0}; pg8::StaticOrder S; S.init(E / 256, vw.MR / 256, vw.vG, vw.vb);
                pg8::EpiVt Ep{WSB(WS_R3) + ro * E, (f32x2*)(ARG_WS + WS_VSTAT) + ro}; pg8::gemm_phase(lds, g, S, Ep, sw); } }
            SEAM_BAR();
            spatial_phase(j, WSB(WS_R1), WSB(WS_R4), WSB(WS_R3), lds, sw, VIEW());
            SEAM_BAR();
            { const View vw = VIEW(); const size_t ro = (size_t)vw.row0;
              pg8::Gemm g{WSB(WS_R4) + ro * E, WSW(6 * MiB), E, E, E, 0}; pg8::StaticOrder S; S.init(vw.MR / 256, D / 256, vw.vG, vw.vb);
              pg8::EpiOut Ep{WSB(WS_R1) + ro * E, (float*)(ARG_WS + WS_SSQ) + ro * 16}; pg8::gemm_phase(lds, g, S, Ep, sw); }
        } else {
            { const View vw = VIEW(); const size_t ro = (size_t)vw.row0;
              pg8::Gemm g{WSB(WS_H) + ro * D, WSW(0), D, D, D, 0}; pg8::StaticOrder S; S.init(vw.MR / 256, E / 256, vw.vG, vw.vb); S.sticky = 1;
              LAS float* cl = (LAS float*)(lds + LDS_GB_OFF);
              { const float* cw = argp(I_BCW) + (size_t)j * 4 * E + (vw.vb % (E / 256)) * 256; const float* cb = argp(I_BCB) + (size_t)j * E + (vw.vb % (E / 256)) * 256; const int t_ = ltid(sw);
                if (t_ < 320) { const int k_ = t_ >> 6, q_ = t_ & 63; *(LAS f32x4*)(cl + k_ * 256 + 4 * q_) = *(const f32x4*)((k_ < 4 ? cw + k_ * E : cb) + 4 * q_); }
                __syncthreads(); }
              pg8::EpiConv Ep{WSB(WS_R3) + ro * E, WSB(WS_R1) + ro * E, cl}; pg8::gemm_phase(lds, g, S, Ep, sw); }
            SEAM_BAR();
            conv_edge_phase(j, WSB(WS_R1), WSB(WS_R3), sw, VIEW());
            SEAM_BAR();
            { const View vw = VIEW(); const size_t ro = (size_t)vw.row0;
              pg8::Gemm g{WSB(WS_R3) + ro * E, WSW(4 * MiB), E, 256, 256, 256}; pg8::StaticOrder S; S.init(vw.MR / 256, 16, vw.vG, vw.vb);
              LAS float* gbl = (LAS float*)(lds + LDS_GB_OFF);
              { const float* s0 = argp(I_BGAB) + j * E; const float* s1 = argp(I_BGXB) + j * E; const float* s2 = (const float*)(ARG_WS + WS_NSP) + j * E; const int t_ = ltid(sw);
                for (int i_ = t_; i_ < E / 4; i_ += 512) { *(LAS f32x4*)(gbl + 4 * i_) = *(const f32x4*)(s0 + 4 * i_); *(LAS f32x4*)(gbl + E + 4 * i_) = *(const f32x4*)(s1 + 4 * i_); *(LAS f32x4*)(gbl + 2 * E + 4 * i_) = *(const f32x4*)(s2 + 4 * i_); }
                __syncthreads(); }
              pg8::EpiGate Ep{WSB(WS_R3) + ro * E, WSB(WS_R1) + ro * E, WSB(WS_R4) + ro * E, gbl, gbl + E, gbl + 2 * E}; pg8::gemm_phase(lds, g, S, Ep, sw); }
            SEAM_BAR();
            { int nst_ = 2; asm volatile("" : "+s"(nst_));
              for (int st_ = 0; st_ < nst_; ++st_) {
                const View vw = VIEW(); const size_t ro = (size_t)vw.row0;
                if (st_ == 0) scan1_phase(WSB(WS_R1), WSB(WS_R4), sw, vw);
                else { pg8::Gemm g{WSB(WS_H) + ro * D, WSW(2 * MiB), D, D, D, 0}; pg8::StaticOrder S; S.init(vw.MR / 256, E / 256, vw.vG, vw.vb);
                       pg8::EpiPlain<0> Ep{WSB(WS_R3) + ro * E, E}; pg8::gemm_phase(lds, g, S, Ep, sw); } } }
            SEAM_BAR();
            scan2_phase(WSB(WS_R1), WSB(WS_R4), WSB(WS_R3), sw, VIEW());
            SEAM_BAR();
            { const View vw = VIEW(); const size_t ro = (size_t)vw.row0;
              pg8::Gemm g{WSB(WS_R3) + ro * E, WSW(6 * MiB), E, E, E, 0}; pg8::StaticOrder S; S.init(vw.MR / 256, D / 256, vw.vG, vw.vb);
              pg8::EpiOut Ep{WSB(WS_R1) + ro * E, (float*)(ARG_WS + WS_SSQ) + ro * 16}; pg8::gemm_phase(lds, g, S, Ep, sw); }
        }
        SEAM_BAR();
        { const View vw = VIEW(); final_phase(l, WSB(WS_R1) + (size_t)vw.row0 * (E - D), sw, vw); }
        if (l + 1 < DEPTH) { convert_layer(l + 1, lds, sw); GRID_BAR(); }
    }
}

extern "C" void kernel_launch(void* const* d_in, const int* in_sizes, int n_in, void* d_out, int out_size, void* d_ws, size_t ws_size, hipStream_t stream) {
    static int grid = 0;
    if (grid == 0) {
        if (n_in != 20 || in_sizes[0] != M * D || out_size != M * D || ws_size < WS_END) { fprintf(stderr, "kernel_launch: unexpected shapes (n_in %d, in0 %d, out %d, ws %zu < %zu); nothing launched\n", n_in, n_in > 0 ? in_sizes[0] : -1, out_size, ws_size, (size_t)WS_END); grid = -1; return; }
        int dev = 0, cus = 0, per_cu = 0;
        if (hipGetDevice(&dev) != hipSuccess || hipDeviceGetAttribute(&cus, hipDeviceAttributeMultiprocessorCount, dev) != hipSuccess) { grid = -1; return; }
        if (hipFuncSetAttribute((const void*)mega_fwd, hipFuncAttributeMaxDynamicSharedMemorySize, LDS_BYTES) != hipSuccess) { fprintf(stderr, "kernel_launch: hipFuncSetAttribute failed\n"); grid = -1; return; }
        if (hipOccupancyMaxActiveBlocksPerMultiprocessor(&per_cu, (const void*)mega_fwd, 512, LDS_BYTES) != hipSuccess || per_cu < 1) { fprintf(stderr, "kernel_launch: occupancy query says %d blocks per CU\n", per_cu); per_cu = 1; }
        (void)hipGetLastError();
        grid = cus;
        if (grid != 256) { fprintf(stderr, "kernel_launch: built for a 256-CU device (scan phases map one workgroup to (batch, 64 channels)); found %d CUs; nothing launched\n", cus); grid = -1; return; }
    }
    if (grid < 0) return;
    (void)hipMemsetAsync((char*)d_ws + WS_CTL, 0, CTL_ZERO_BYTES, stream);
    Args a{};
    for (int i = 0; i < 20; ++i) a.in[i] = (const float*)d_in[i];
    a.out = (float*)d_out; a.ws = (unsigned char*)d_ws;
    void* args[] = {&a};
    const hipError_t e = hipLaunchCooperativeKernel((const void*)mega_fwd, dim3(grid), dim3(512), args, LDS_BYTES, stream);
    if (e != hipSuccess) fprintf(stderr, "kernel_launch: cooperative launch failed: %s (grid %d)\n", hipGetErrorString(e), grid);
}
```
